# Optimizing an MI355X kernel written in HIP

```python
import math
import jax, jax.numpy as jnp
from jax import lax
import numpy as np

D_MODEL = 1024
BATCH = 8
SEQ = 2048
DEPTH = 2

N_A_LAYERS = DEPTH // 2
N_B_LAYERS = DEPTH - N_A_LAYERS
RET_HEADS = 4
RET_QK_DIM = D_MODEL // RET_HEADS
RET_V_DIM = 2 * RET_QK_DIM
RET_CHUNK = 128
DIFF_HEAD_DIM = 64
DIFF_HEADS = D_MODEL // (2 * DIFF_HEAD_DIM)
Q_BLOCK = 128
D_FF = ((8 * D_MODEL // 3 + 127) // 128) * 128
CONV_WIDTH = 3
ROPE_BASE = 10000.0
EPS = 1e-6

kernel_name = "yoco_retention_diffattn_convffn"


def rms_norm(x, g=None):
    xf = x.astype(jnp.float32)
    y = xf * lax.rsqrt(jnp.mean(xf * xf, axis=-1, keepdims=True) + EPS)
    if g is not None:
        y = y * g.astype(jnp.float32)
    return y.astype(x.dtype)


def rotary(x, pos):
    half = x.shape[-1] // 2
    inv = 1.0 / (ROPE_BASE ** jnp.linspace(0.0, 1.0, half, dtype=jnp.float32))
    ang = pos.astype(jnp.float32)[:, None] * inv[None, :]
    cos = jnp.cos(ang)[None, :, None, :]
    sin = jnp.sin(ang)[None, :, None, :]
    xf = x.astype(jnp.float32)
    x1, x2 = xf[..., :half], xf[..., half:]
    return jnp.concatenate([x1 * cos - x2 * sin, x1 * sin + x2 * cos], axis=-1).astype(x.dtype)


def retention(xn, w_in, w_out):
    B, S, _ = xn.shape
    H, dk, dv, C = RET_HEADS, RET_QK_DIM, RET_V_DIM, RET_CHUNK
    dt = xn.dtype
    proj = xn @ w_in
    q, k, v, g = jnp.split(proj, [H * dk, 2 * H * dk, 2 * H * dk + H * dv], axis=-1)
    pos = jnp.arange(S)
    q = rotary(q.reshape(B, S, H, dk), pos)
    k = rotary(k.reshape(B, S, H, dk), pos) * (dk ** -0.5)
    v = v.reshape(B, S, H, dv)

    log_gamma = jnp.log1p(-jnp.power(2.0, -5.0 - jnp.arange(H, dtype=jnp.float32)))
    idx = jnp.arange(C, dtype=jnp.float32)
    rel = idx[:, None] - idx[None, :]
    decay_mask = jnp.where(rel[None] >= 0,
                           jnp.exp(log_gamma[:, None, None] * jnp.maximum(rel, 0.0)[None]),
                           0.0).astype(dt)
    q_decay = jnp.exp(log_gamma[None, :] * (idx[:, None] + 1.0)).astype(dt)
    k_decay = jnp.exp(log_gamma[None, :] * (C - 1.0 - idx[:, None])).astype(dt)
    chunk_decay = jnp.exp(log_gamma * C).astype(dt)

    n = S // C

    def to_chunks(t):
        return jnp.moveaxis(t.reshape(B, n, C, H, t.shape[-1]), 1, 0)

    def step(state, qkv):
        qc, kc, vc = qkv
        s = jnp.einsum('bihd,bjhd->bhij', qc, kc) * decay_mask[None]
        inner = jnp.einsum('bhij,bjhe->bihe', s, vc)
        cross = jnp.einsum('bihd,bhde->bihe', qc * q_decay[None, :, :, None], state)
        new_state = (state * chunk_decay[None, :, None, None]
                     + jnp.einsum('bjhd,bjhe->bhde', kc * k_decay[None, :, :, None], vc))
        return new_state, inner + cross

    state0 = jnp.zeros((B, H, dk, dv), dt)
    _, out = lax.scan(step, state0, (to_chunks(q), to_chunks(k), to_chunks(v)))
    out = jnp.moveaxis(out, 0, 1).reshape(B, S, H, dv)
    out = rms_norm(out).reshape(B, S, H * dv)
    return (jax.nn.silu(g) * out) @ w_out


def diff_attention(xn, k_sh, v_sh, w_q, lam_params, subln_g, w_out, lambda_init):
    B, S, _ = xn.shape
    H, d = DIFF_HEADS, DIFF_HEAD_DIM
    q = (xn @ w_q).reshape(B, S, H, 2, d) * (d ** -0.5)
    nb = S // Q_BLOCK
    q_blocks = jnp.moveaxis(q.reshape(B, nb, Q_BLOCK, H, 2, d), 1, 0)
    lp = lam_params.astype(jnp.float32)
    lam = jnp.exp(jnp.sum(lp[0] * lp[1])) - jnp.exp(jnp.sum(lp[2] * lp[3])) + lambda_init
    kpos = jnp.arange(S)

    def block(args):
        i, qb = args
        qpos = i * Q_BLOCK + jnp.arange(Q_BLOCK)
        s = jnp.einsum('bqhcd,bkhcd->bhcqk', qb, k_sh).astype(jnp.float32)
        s = jnp.where(kpos[None, :] <= qpos[:, None], s, -jnp.inf)
        p = jax.nn.softmax(s, axis=-1)
        a = p[:, :, 0] - lam * p[:, :, 1]
        return jnp.einsum('bhqk,bkhe->bqhe', a.astype(v_sh.dtype), v_sh)

    o = lax.map(block, (jnp.arange(nb), q_blocks))
    o = jnp.moveaxis(o, 0, 1).reshape(B, S, H, 2 * d)
    o = rms_norm(o, subln_g) * (1.0 - lambda_init)
    return o.reshape(B, S, H * 2 * d) @ w_out


def conv_ffn(xn, w_up, conv_w, conv_b, w_down):
    S = xn.shape[1]
    h = xn @ w_up
    hp = jnp.pad(h, ((0, 0), (CONV_WIDTH - 1, 0), (0, 0)))
    hc = conv_b
    for j in range(CONV_WIDTH):
        hc = hc + hp[:, j:j + S] * conv_w[j]
    g, u = jnp.split(hc, 2, axis=-1)
    return (jax.nn.silu(g) * u) @ w_down


def setup_inputs(seed: int = 0) -> dict:
    key = jax.random.key(seed)
    ks = jax.random.split(key, 24)
    D, F = D_MODEL, D_FF
    ret_in = 2 * RET_HEADS * RET_QK_DIM + 2 * RET_HEADS * RET_V_DIM
    ret_v = RET_HEADS * RET_V_DIM
    diff_w = DIFF_HEADS * 2 * DIFF_HEAD_DIM

    def w(k, shape, fan_in):
        return jax.random.normal(k, shape, jnp.float32) * (fan_in ** -0.5)

    def gain(k, shape):
        return 1.0 + 0.02 * jax.random.normal(k, shape, jnp.float32)

    return {
        "x": jax.random.normal(ks[0], (BATCH, SEQ, D), jnp.float32),
        "a_norm_pre": gain(ks[1], (N_A_LAYERS, D)),
        "a_norm_post": gain(ks[2], (N_A_LAYERS, D)),
        "a_w_in": w(ks[3], (N_A_LAYERS, D, ret_in), D),
        "a_w_out": w(ks[4], (N_A_LAYERS, ret_v, D), ret_v),
        "kv_norm": gain(ks[5], (D,)),
        "w_kv": w(ks[6], (D, 2 * diff_w), D),
        "b_norm_pre": gain(ks[7], (N_B_LAYERS, D)),
        "b_norm_post": gain(ks[8], (N_B_LAYERS, D)),
        "b_w_q": w(ks[9], (N_B_LAYERS, D, diff_w), D),
        "b_lambda": 0.1 * jax.random.normal(ks[10], (N_B_LAYERS, 4, DIFF_HEAD_DIM), jnp.float32),
        "b_subln": gain(ks[11], (N_B_LAYERS, 2 * DIFF_HEAD_DIM)),
        "b_w_out": w(ks[12], (N_B_LAYERS, diff_w, D), diff_w),
        "ffn_norm_pre": gain(ks[13], (DEPTH, D)),
        "ffn_norm_post": gain(ks[14], (DEPTH, D)),
        "ffn_w_up": w(ks[15], (DEPTH, D, 2 * F), D),
        "ffn_conv_w": w(ks[16], (DEPTH, CONV_WIDTH, 2 * F), CONV_WIDTH),
        "ffn_conv_b": 0.02 * jax.random.normal(ks[17], (DEPTH, 2 * F), jnp.float32),
        "ffn_w_down": w(ks[18], (DEPTH, F, D), F),
    }


def reference(x, a_norm_pre, a_norm_post, a_w_in, a_w_out, kv_norm, w_kv,
              b_norm_pre, b_norm_post, b_w_q, b_lambda, b_subln, b_w_out,
              ffn_norm_pre, ffn_norm_post, ffn_w_up, ffn_conv_w, ffn_conv_b, ffn_w_down):
    B, S, _ = x.shape
    H, d = DIFF_HEADS, DIFF_HEAD_DIM
    k_sh = None
    v_sh = None
    for layer in range(DEPTH):
        if layer < N_A_LAYERS:
            i = layer
            h = retention(rms_norm(x, a_norm_pre[i]), a_w_in[i], a_w_out[i])
            x = x + rms_norm(h, a_norm_post[i])
        else:
            i = layer - N_A_LAYERS
            if i == 0:
                kv = rms_norm(x, kv_norm) @ w_kv
                k_flat, v_flat = jnp.split(kv, 2, axis=-1)
                k_sh = k_flat.reshape(B, S, H, 2, d)
                v_sh = v_flat.reshape(B, S, H, 2 * d)
            lambda_init = 0.8 - 0.6 * math.exp(-0.3 * layer)
            h = diff_attention(rms_norm(x, b_norm_pre[i]), k_sh, v_sh, b_w_q[i],
                               b_lambda[i], b_subln[i], b_w_out[i], lambda_init)
            x = x + rms_norm(h, b_norm_post[i])
        h = conv_ffn(rms_norm(x, ffn_norm_pre[layer]), ffn_w_up[layer],
                     ffn_conv_w[layer], ffn_conv_b[layer], ffn_w_down[layer])
        x = x + rms_norm(h, ffn_norm_post[layer])
    return x
```

```cpp
#include <hip/hip_runtime.h>
#include <hip/hip_bf16.h>
#include <hip/hip_cooperative_groups.h>
#include <cstdio>
#include <cstdint>
#include <cmath>
namespace cg = cooperative_groups;

#ifndef MK_N_LAUNCHES
#define MK_N_LAUNCHES 19
#endif

namespace pg8 {
#define PG8_LAS __attribute__((address_space(3)))
typedef unsigned short bf16_t;
typedef short bf16x8 __attribute__((ext_vector_type(8)));
typedef float f32x4 __attribute__((ext_vector_type(4)));
typedef unsigned u32x4 __attribute__((ext_vector_type(4)));
constexpr int BM = 256, BK = 64, HALF = 128, HTB = HALF * BK * 2  , STAGE_BYTES = 8 * HTB, NXCD = 8, WGM = 8;

__host__ __device__ __forceinline__ int lds_byte(int r, int c) { const int st = (r >> 4) * 2 + (c >> 5), rr = r & 15, cc = c & 31, ob = rr * 64 + cc * 2; return st * 1024 + (ob ^ (((ob >> 9) & 1) << 5)); }
__host__ __device__ __forceinline__ void stage_rc(int b, int& R, int& C) { const int st = b / 1024, sb = b % 1024, swz = sb ^ (((sb >> 9) & 1) << 5); R = (st >> 1) * 16 + swz / 64; C = (st & 1) * 32 + (swz % 64) / 2; }
__host__ __device__ __forceinline__ int perm32(int rho) { const int n = rho >> 4, i = rho & 15; return 8 * (i >> 2) + 4 * n + (i & 3); }

struct Unit { int pm, pn; };
struct Gemm { const bf16_t* A; const bf16_t* Bt; int M, N, K, lda; };

struct StaticOrder {
    int nM, nN, nwg, G, c;
    __host__ __device__ void init(int M, int N, int G_, int c_) { nM = M / BM; nN = N / BM; nwg = nM * nN; G = G_; c = c_; }
    __host__ __device__ bool next(int i, Unit& u) const {
        const long L = (long)i * G + c; if (L >= nwg) return false;
        int wgid = (int)L; { const int q = nwg / NXCD, r = nwg % NXCD, xcd = wgid % NXCD, off = wgid / NXCD; wgid = (xcd < r ? xcd * (q + 1) : r * (q + 1) + (xcd - r) * q) + off; }
        const int nig = WGM * nN, gid = wgid / nig, fm = gid * WGM, gsz = (nM - fm) < WGM ? (nM - fm) : WGM;
        u.pm = fm + ((wgid % nig) % gsz); u.pn = (wgid % nig) / gsz; return true;
    }
    __device__ __forceinline__ void a_ready(const Unit&) const {}
    __device__ __forceinline__ void done(const Unit&) const {}
};

__device__ __forceinline__ unsigned cvt_pk_bf16(float lo, float hi) { unsigned r; asm volatile("v_cvt_pk_bf16_f32 %0, %1, %2" : "=v"(r) : "v"(lo), "v"(hi)); return r; }

struct EpiOut {
    static constexpr bool PERM = true, AFTER_DRAIN = false;
    bf16_t* O; int ldc; int split_cols; size_t split_stride; float scale0; bf16_t* side; int side_pn; int side_ld;
    __device__ __forceinline__ void operator()(const f32x4 (&acc)[2][2][4][2], const Unit& u, int wr, int wc, int fr, int fq) const {
        const int row0 = u.pm * BM + wr * 64 + fr; int colt = u.pn * BM; bf16_t* base = O;
        float sc = 1.f; if (split_cols) { const int t = colt / split_cols; base += (size_t)t * split_stride; colt -= t * split_cols; if (t == 0) sc = scale0; }
        const int col0 = colt + wc * 32 + 8 * fq;
        const bool do_side = (side != nullptr) && (u.pn < side_pn);
#pragma unroll
        for (int ai = 0; ai < 2; ++ai)
#pragma unroll
            for (int m = 0; m < 4; ++m) { const int row = row0 + ai * HALF + m * 16; bf16_t* rowp = base + (size_t)row * ldc + col0;
#pragma unroll
                for (int bj = 0; bj < 2; ++bj) { f32x4 v0 = acc[ai][bj][m][0] * sc, v1 = acc[ai][bj][m][1] * sc;
                    u32x4 w; w.x = cvt_pk_bf16(v0[0], v0[1]); w.y = cvt_pk_bf16(v0[2], v0[3]); w.z = cvt_pk_bf16(v1[0], v1[1]); w.w = cvt_pk_bf16(v1[2], v1[3]);
                    *(u32x4*)(rowp + bj * HALF) = w;
                    if (m == 3) { if (do_side && fr >= 14) *(u32x4*)(side + (size_t)((row >> 6) * 2 + (fr - 14)) * side_ld + col0 + bj * HALF) = w; } } }
    }
};

struct EpiProj {
    static constexpr bool PERM = true, AFTER_DRAIN = false;
    bf16_t* O; int ldc; const float* cosT; const float* sinT;
    __device__ __forceinline__ void operator()(const f32x4 (&acc)[2][2][4][2], const Unit& u, int wr, int wc, int fr, int fq) const {
        const int row0 = u.pm * BM + wr * 64 + fr; const int colt = u.pn * BM; const int j0 = wc * 32 + 8 * fq; const int col0 = colt + j0;
        const int kind = u.pn < 8 ? 0 : (u.pn < 16 ? 1 : 2);
        const float ksc = (u.pn >= 4) ? 0.0625f : 1.0f;
#pragma unroll
        for (int ai = 0; ai < 2; ++ai)
#pragma unroll
            for (int m = 0; m < 4; ++m) { const int row = row0 + ai * HALF + m * 16; bf16_t* rowp = O + (size_t)row * ldc + col0;
                f32x4 o[2][2];
                if (kind == 0) { const int pos = row & 2047;
#pragma unroll
                    for (int n = 0; n < 2; ++n) { const f32x4 c4 = *(const f32x4*)(cosT + pos * 128 + j0 + 4 * n), s4 = *(const f32x4*)(sinT + pos * 128 + j0 + 4 * n);
                        const f32x4 x1 = acc[ai][0][m][n], x2 = acc[ai][1][m][n];
                        o[0][n] = (x1 * c4 - x2 * s4) * ksc; o[1][n] = (x1 * s4 + x2 * c4) * ksc; }
                } else if (kind == 1) {
#pragma unroll
                    for (int bj = 0; bj < 2; ++bj)
#pragma unroll
                        for (int n = 0; n < 2; ++n) o[bj][n] = acc[ai][bj][m][n];
                } else {
#pragma unroll
                    for (int bj = 0; bj < 2; ++bj)
#pragma unroll
                        for (int n = 0; n < 2; ++n) { const f32x4 v = acc[ai][bj][m][n]; f32x4 r;
#pragma unroll
                            for (int e = 0; e < 4; ++e) r[e] = v[e] * __builtin_amdgcn_rcpf(1.0f + __expf(-v[e]));
                            o[bj][n] = r; }
                }
#pragma unroll
                for (int bj = 0; bj < 2; ++bj) { u32x4 w; w.x = cvt_pk_bf16(o[bj][0][0], o[bj][0][1]); w.y = cvt_pk_bf16(o[bj][0][2], o[bj][0][3]); w.z = cvt_pk_bf16(o[bj][1][0], o[bj][1][1]); w.w = cvt_pk_bf16(o[bj][1][2], o[bj][1][3]);
                    *(u32x4*)(rowp + bj * HALF) = w; } }
    }
};

template <class Epi, class Sched, bool ALIGN_EPI = false, bool SP2 = false>
__device__ __forceinline__ void gemm_phase(PG8_LAS unsigned char* lds, const Gemm g, const Sched& S, const Epi& E) {
    const int tid = threadIdx.x, wid = __builtin_amdgcn_readfirstlane(tid >> 6), lane = tid & 63, wr = wid >> 2, wc = wid & 3, fr = lane & 15, fq = lane >> 4;
    const int K = g.K, nt = K / BK;
    unsigned voffA[2], voffB[2];
#pragma unroll
    for (int i = 0; i < 2; ++i) { int R, C; stage_rc(tid * 16 + i * 8192, R, C); const int Rb = Epi::PERM ? ((R & ~31) + perm32(R & 31)) : R;
        voffA[i] = (unsigned)(R * g.lda + C) * 2u; voffB[i] = (unsigned)(Rb * K + C) * 2u; }
    const size_t kstep = (size_t)(BK * 2);
    const size_t hsB = (size_t)HALF * K * 2, hsA = (size_t)HALF * g.lda * 2;
    const size_t tsA = 2 * hsA, tsB = 2 * hsB;
    const unsigned ldsw = (unsigned)wid * 1024u;
    const int aoff = lds_byte(wr * 64 + fr, fq * 8), boff = lds_byte(wc * 32 + fr, fq * 8);
#define PG8_SA(b, h) (((b) * 2 + (h)) * HTB)
#define PG8_SB(b, h) ((4 + (b) * 2 + (h)) * HTB)
#define PG8_STAGE(bufoff, gbase, voff) do { _Pragma("unroll") for (int _i = 0; _i < 2; ++_i) \
        __builtin_amdgcn_global_load_lds((const unsigned*)((const char*)(gbase) + (voff)[_i]), (PG8_LAS unsigned*)(lds + (bufoff) + ldsw + _i * 8192), 16, 0, 0); } while (0)
#define PG8_LDA(dst, b, h) do { _Pragma("unroll") for (int m = 0; m < 4; ++m) _Pragma("unroll") for (int k = 0; k < 2; ++k) dst[m][k] = *(const PG8_LAS bf16x8*)(lds + PG8_SA(b, h) + aoff + m * 2048 + k * 1024); } while (0)
#define PG8_LDB(dst, b, h) do { _Pragma("unroll") for (int n = 0; n < 2; ++n) _Pragma("unroll") for (int k = 0; k < 2; ++k) dst[n][k] = *(const PG8_LAS bf16x8*)(lds + PG8_SB(b, h) + boff + n * 2048 + k * 1024); } while (0)
#define PG8_MMA(ai, bj, At, Bt) do { __builtin_amdgcn_s_setprio(1); _Pragma("unroll") for (int m = 0; m < 4; ++m) _Pragma("unroll") for (int n = 0; n < 2; ++n) _Pragma("unroll") for (int k = 0; k < 2; ++k) \
        acc[ai][bj][m][n] = __builtin_amdgcn_mfma_f32_16x16x32_bf16(Bt[n][k], At[m][k], acc[ai][bj][m][n], 0, 0, 0); __builtin_amdgcn_s_setprio(0); } while (0)
#define PG8_WAIT_V(n) asm volatile("s_waitcnt vmcnt(" #n ")" ::: "memory")
#define PG8_WAIT_L(n) asm volatile("s_waitcnt lgkmcnt(" #n ")" ::: "memory")
#define PG8_BAR __builtin_amdgcn_s_barrier()
#define PG8_SCHED __builtin_amdgcn_sched_barrier(0)
    Unit cur, nxt; int ui = 0;
    if (!S.next(0, cur)) return;
    f32x4 acc[2][2][4][2];
#pragma unroll
    for (int a = 0; a < 2; ++a)
#pragma unroll
        for (int b = 0; b < 2; ++b)
#pragma unroll
            for (int m = 0; m < 4; ++m)
#pragma unroll
                for (int n = 0; n < 2; ++n) acc[a][b][m][n] = (f32x4){0.f, 0.f, 0.f, 0.f};
    bf16x8 At[4][2], B0[2][2], B1[2][2];
    const char* cA = (const char*)g.A + (size_t)cur.pm * tsA; const char* cB = (const char*)g.Bt + (size_t)cur.pn * tsB;
    S.a_ready(cur);
    if constexpr (SP2) {
        PG8_STAGE(PG8_SB(0, 0), cB, voffB); PG8_STAGE(PG8_SB(0, 1), cB + hsB, voffB); PG8_STAGE(PG8_SA(0, 0), cA, voffA); PG8_STAGE(PG8_SA(0, 1), cA + hsA, voffA);
        if (wr == 1) PG8_BAR;
        PG8_WAIT_V(2); PG8_BAR;
        PG8_STAGE(PG8_SB(1, 0), cB + kstep, voffB); PG8_STAGE(PG8_SA(1, 0), cA + kstep, voffA); PG8_STAGE(PG8_SB(1, 1), cB + hsB + kstep, voffB);
        PG8_WAIT_V(6); PG8_BAR;
    } else {
        PG8_STAGE(PG8_SB(0, 0), cB, voffB); PG8_STAGE(PG8_SA(0, 0), cA, voffA); PG8_STAGE(PG8_SB(0, 1), cB + hsB, voffB); PG8_STAGE(PG8_SA(0, 1), cA + hsA, voffA);
        if (wr == 1) PG8_BAR;
        PG8_WAIT_V(4); PG8_BAR;
        PG8_STAGE(PG8_SB(1, 0), cB + kstep, voffB); PG8_STAGE(PG8_SA(1, 0), cA + kstep, voffA); PG8_STAGE(PG8_SB(1, 1), cB + hsB + kstep, voffB);
        PG8_WAIT_V(6); PG8_BAR;
    }
    for (;;) {
        const bool has_next = S.next(ui + 1, nxt);
        const char* nA = has_next ? (const char*)g.A + (size_t)nxt.pm * tsA : cA; const char* nB = has_next ? (const char*)g.Bt + (size_t)nxt.pn * tsB : cB;
        for (int t = 0; t < nt; t += 2) {
            const bool last = (t == nt - 2);
            const char* a1 = cA + (size_t)(t + 1) * kstep;
            const char* a2 = last ? nA : cA + (size_t)(t + 2) * kstep; const char* b2 = last ? nB : cB + (size_t)(t + 2) * kstep;
            const char* a3 = a2 + kstep; const char* b3 = b2 + kstep;
            if (last && has_next) S.a_ready(nxt);
            if constexpr (SP2) {
            PG8_LDB(B0, 0, 0); PG8_LDB(B1, 0, 1); PG8_SCHED; PG8_LDA(At, 0, 0); PG8_STAGE(PG8_SA(1, 1), a1 + hsA, voffA);
            PG8_WAIT_V(8); PG8_WAIT_L(0); PG8_BAR; PG8_MMA(0, 0, At, B0); PG8_MMA(0, 1, At, B1); PG8_BAR; PG8_SCHED;
            PG8_LDA(At, 0, 1); PG8_STAGE(PG8_SB(0, 0), b2, voffB); PG8_STAGE(PG8_SB(0, 1), b2 + hsB, voffB); PG8_STAGE(PG8_SA(0, 0), a2, voffA);
            PG8_WAIT_V(8); PG8_WAIT_L(0); PG8_BAR; PG8_MMA(1, 0, At, B0); PG8_MMA(1, 1, At, B1); PG8_BAR; PG8_SCHED;
            PG8_LDB(B0, 1, 0); PG8_LDB(B1, 1, 1); PG8_SCHED; PG8_LDA(At, 1, 0); PG8_STAGE(PG8_SA(0, 1), a2 + hsA, voffA);
            PG8_WAIT_V(8); PG8_WAIT_L(0); PG8_BAR; PG8_MMA(0, 0, At, B0); PG8_MMA(0, 1, At, B1); PG8_BAR; PG8_SCHED;
            PG8_LDA(At, 1, 1); PG8_STAGE(PG8_SB(1, 0), b3, voffB); PG8_STAGE(PG8_SB(1, 1), b3 + hsB, voffB); PG8_STAGE(PG8_SA(1, 0), a3, voffA);
            PG8_WAIT_V(8); PG8_WAIT_L(0); PG8_BAR; PG8_MMA(1, 0, At, B0); PG8_MMA(1, 1, At, B1); PG8_BAR; PG8_SCHED;
            } else {
            PG8_LDB(B0, 0, 0); PG8_SCHED; PG8_LDA(At, 0, 0); PG8_STAGE(PG8_SA(1, 1), a1 + hsA, voffA);
            PG8_WAIT_L(8); PG8_BAR; PG8_WAIT_L(0); PG8_MMA(0, 0, At, B0); PG8_BAR; PG8_SCHED;
            PG8_LDB(B1, 0, 1); PG8_STAGE(PG8_SB(0, 0), b2, voffB);
            PG8_BAR; PG8_WAIT_L(0); PG8_MMA(0, 1, At, B1); PG8_BAR;
            PG8_LDA(At, 0, 1); PG8_STAGE(PG8_SA(0, 0), a2, voffA);
            PG8_BAR; PG8_WAIT_L(0); PG8_MMA(1, 0, At, B0); PG8_BAR; PG8_SCHED;
            PG8_STAGE(PG8_SB(0, 1), b2 + hsB, voffB);
            PG8_WAIT_V(6); PG8_BAR; PG8_MMA(1, 1, At, B1); PG8_BAR;
            PG8_LDB(B0, 1, 0); PG8_SCHED; PG8_LDA(At, 1, 0); PG8_STAGE(PG8_SA(0, 1), a2 + hsA, voffA);
            PG8_WAIT_L(8); PG8_BAR; PG8_WAIT_L(0); PG8_MMA(0, 0, At, B0); PG8_BAR; PG8_SCHED;
            PG8_LDB(B1, 1, 1); PG8_STAGE(PG8_SB(1, 0), b3, voffB);
            PG8_BAR; PG8_WAIT_L(0); PG8_MMA(0, 1, At, B1); PG8_BAR;
            PG8_LDA(At, 1, 1); PG8_STAGE(PG8_SA(1, 0), a3, voffA);
            PG8_BAR; PG8_WAIT_L(0); PG8_MMA(1, 0, At, B0); PG8_BAR; PG8_SCHED;
            PG8_STAGE(PG8_SB(1, 1), b3 + hsB, voffB);
            PG8_WAIT_V(6); PG8_BAR; PG8_MMA(1, 1, At, B1); PG8_BAR;
            }
        }
        if constexpr (ALIGN_EPI) { if (wr == 0) PG8_BAR; }
        if constexpr (!Epi::AFTER_DRAIN) { E(acc, cur, wr, wc, fr, fq); S.done(cur); }
        if (!has_next) break;
#pragma unroll
        for (int a = 0; a < 2; ++a)
#pragma unroll
            for (int b = 0; b < 2; ++b)
#pragma unroll
                for (int m = 0; m < 4; ++m)
#pragma unroll
                    for (int n = 0; n < 2; ++n) acc[a][b][m][n] = (f32x4){0.f, 0.f, 0.f, 0.f};
        cur = nxt; cA = nA; cB = nB; ++ui;
        if constexpr (ALIGN_EPI) { if (wr == 1) PG8_BAR; }
    }
    PG8_WAIT_V(0);
    if constexpr (!ALIGN_EPI) { if (wr == 0) PG8_BAR; }
    PG8_BAR;
    if constexpr (Epi::AFTER_DRAIN) { E.fused(acc, cur, wr, wc, fr, fq, lds, wid, lane); S.done(cur); }
#undef PG8_SA
#undef PG8_SB
#undef PG8_STAGE
#undef PG8_LDA
#undef PG8_LDB
#undef PG8_MMA
#undef PG8_WAIT_V
#undef PG8_WAIT_L
#undef PG8_BAR
#undef PG8_SCHED
}
}
namespace attn_body {
using bf16=__hip_bfloat16;
using bf16x8=__attribute__((ext_vector_type(8)))short;
using s16x4=__attribute__((ext_vector_type(4)))short;
using f32x16=__attribute__((ext_vector_type(16)))float;
using u32x4=__attribute__((ext_vector_type(4)))unsigned;
constexpr int BATCH=8,NHEAD=16,SEQ=2048,D=64,DM=1024;
constexpr int NW=8,QBLK=32,QB=QBLK*NW,KVBLK=64,NQB=SEQ/QB;
constexpr int ATTN_PITCH=DM, ATTN_UNIT_ROWS=QB;
__device__ __forceinline__ int crow(int r,int hi){return (r&3)+8*(r>>2)+4*hi;}
#define SBAR() __builtin_amdgcn_sched_barrier(0)
__device__ __forceinline__ void cmask(f32x16&p0,f32x16&p1,int jb,int qrel,int hi){
  const float NEG=-INFINITY; int kb=64*jb+4*hi;
  #pragma unroll
  for(int r=0;r<16;++r){int kv=kb+(r&3)+8*(r>>2); if(kv>qrel)p0[r]=NEG; if(kv+32>qrel)p1[r]=NEG;}
}

constexpr int NSLOT=3, SLOTB=8192;
constexpr int LDS_K=0, LDS_V=NSLOT*SLOTB, LDS_WS=2*NSLOT*SLOTB, LDS_OST=LDS_WS+NW*64*4, LDS_BYTES=LDS_OST+NW*4096;
constexpr float C2=0.125f*1.4426950408889634f;
__device__ __forceinline__ void glds16(const void*gsrc,unsigned lds_dst){unsigned keep;
  asm volatile("s_mov_b32 %0, m0\n\ts_mov_b32 m0, %2\n\ts_nop 0\n\tglobal_load_lds_dwordx4 %1, off\n\ts_mov_b32 m0, %0":"=&s"(keep):"v"(gsrc),"s"(lds_dst):"memory");}
__device__ __forceinline__ float max3f(float a,float b,float c){float r;asm("v_max3_f32 %0, %1, %2, %3":"=v"(r):"v"(a),"v"(b),"v"(c));return r;}
__device__ __forceinline__ float max2f(float a,float b){float r;asm("v_max_f32_e32 %0, %1, %2":"=v"(r):"v"(a),"v"(b));return r;}
__device__ __forceinline__ float fadd_s(float a,float b){float r;asm("v_add_f32_e32 %0, %1, %2":"=v"(r):"v"(a),"v"(b));return r;}
__device__ __forceinline__ float fsub_s(float a,float b){float r;asm("v_sub_f32_e32 %0, %1, %2":"=v"(r):"v"(a),"v"(b));return r;}
typedef float f32x2_t __attribute__((ext_vector_type(2))); typedef __bf16 bf16x2_t __attribute__((ext_vector_type(2)));
__device__ __forceinline__ unsigned cvtpk_s(float lo,float hi){f32x2_t v={lo,hi};bf16x2_t b=__builtin_convertvector(v,bf16x2_t);return __builtin_bit_cast(unsigned,b);}
#define WAIT_BAR(N) asm volatile("s_waitcnt vmcnt(" #N ") lgkmcnt(0)\n\ts_barrier":::"memory")

__device__ __forceinline__ void qkt(f32x16&p0,f32x16&p1,const char*Kslot,const bf16x8*qr,const f32x16&negm,int r32,int hi){
  const char*kb=Kslot+hi*1024+r32*16;
  #pragma unroll
  for(int d0=0;d0<4;++d0){
    const bf16x8 b0=*reinterpret_cast<const bf16x8*>(kb+d0*2048);
    const bf16x8 b1=*reinterpret_cast<const bf16x8*>(kb+d0*2048+512);
    if(d0==0){p0=__builtin_amdgcn_mfma_f32_32x32x16_bf16(b0,qr[0],negm,0,0,0);p1=__builtin_amdgcn_mfma_f32_32x32x16_bf16(b1,qr[0],negm,0,0,0);}
    else{p0=__builtin_amdgcn_mfma_f32_32x32x16_bf16(b0,qr[d0],p0,0,0,0);p1=__builtin_amdgcn_mfma_f32_32x32x16_bf16(b1,qr[d0],p1,0,0,0);}}
}
typedef __attribute__((address_space(3))) const char* lds_cptr;
typedef short v4i16_t __attribute__((ext_vector_type(4)));
__device__ __forceinline__ void kload8(bf16x8*kf,lds_cptr kp){
  kf[0]=*(const __attribute__((address_space(3))) bf16x8*)(kp);      kf[1]=*(const __attribute__((address_space(3))) bf16x8*)(kp+512);
  kf[2]=*(const __attribute__((address_space(3))) bf16x8*)(kp+2048); kf[3]=*(const __attribute__((address_space(3))) bf16x8*)(kp+2560);
  kf[4]=*(const __attribute__((address_space(3))) bf16x8*)(kp+4096); kf[5]=*(const __attribute__((address_space(3))) bf16x8*)(kp+4608);
  kf[6]=*(const __attribute__((address_space(3))) bf16x8*)(kp+6144); kf[7]=*(const __attribute__((address_space(3))) bf16x8*)(kp+6656);
}
__device__ __forceinline__ void kload2(bf16x8*kf,lds_cptr kp,int j){ kf[2*j]=*(const __attribute__((address_space(3))) bf16x8*)(kp+j*2048); kf[2*j+1]=*(const __attribute__((address_space(3))) bf16x8*)(kp+j*2048+512); }
__device__ __forceinline__ s16x4 vtr(lds_cptr p){ return __builtin_bit_cast(s16x4,__builtin_amdgcn_ds_read_tr16_b64_v4i16((__attribute__((address_space(3))) v4i16_t*)p)); }
__device__ __forceinline__ float rowmax(const f32x16&p0,const f32x16&p1){
  float a=max3f(p0[0],p0[1],p1[0]),b=max3f(p0[2],p0[3],p1[1]);a=max3f(a,p1[2],p1[3]);
  #pragma unroll
  for(int r=4;r<16;r+=4){a=max3f(a,p0[r],p0[r+1]);b=max3f(b,p0[r+2],p0[r+3]);a=max3f(a,p1[r],p1[r+1]);b=max3f(b,p1[r+2],p1[r+3]);}
  const float m=max2f(a,b);
  auto rr=__builtin_amdgcn_permlane32_swap(__float_as_uint(m),__float_as_uint(m),false,false);
  return max2f(__uint_as_float(rr[0]),__uint_as_float(rr[1]));
}
__device__ __forceinline__ void pv(f32x16*o,int vb,bf16x8 pa0,bf16x8 pa1,bf16x8 pa2,bf16x8 pa3){
  #pragma unroll
  for(int d0=0;d0<2;++d0){s16x4 lo[4],hi[4];
    #pragma unroll
    for(int ks=0;ks<4;++ks){
      asm volatile("ds_read_b64_tr_b16 %0,%1 offset:%c2":"=&v"(lo[ks]):"v"(vb),"i"(d0*4096+ks*1024):"memory");
      asm volatile("ds_read_b64_tr_b16 %0,%1 offset:%c2":"=&v"(hi[ks]):"v"(vb),"i"(d0*4096+ks*1024+512):"memory");}
    asm volatile("s_waitcnt lgkmcnt(0)":::"memory");SBAR();
    #define PK(k) (bf16x8){lo[k][0],lo[k][1],lo[k][2],lo[k][3],hi[k][0],hi[k][1],hi[k][2],hi[k][3]}
    o[d0]=__builtin_amdgcn_mfma_f32_32x32x16_bf16(pa0,PK(0),o[d0],0,0,0);
    o[d0]=__builtin_amdgcn_mfma_f32_32x32x16_bf16(pa1,PK(1),o[d0],0,0,0);
    o[d0]=__builtin_amdgcn_mfma_f32_32x32x16_bf16(pa2,PK(2),o[d0],0,0,0);
    o[d0]=__builtin_amdgcn_mfma_f32_32x32x16_bf16(pa3,PK(3),o[d0],0,0,0);
    #undef PK
  }
}

#ifndef ATTN_STORE16
#define ATTN_STORE16(p,v) (*(u32x4*)(p)=(v))
#endif
template<int THRL> __device__ __forceinline__ void attn_unit(int b,int qkcol,int vcol,int qb,const bf16*Q,const bf16*__restrict__ K,const bf16*__restrict__ V,bf16*O,char*shm){
  const int tid=threadIdx.x,lane=tid&63,r32=lane&31,hi=lane>>5; const int wid=__builtin_amdgcn_readfirstlane(tid>>6);
  const long rowbase=(long)b*SEQ; const int q0=qb*QB;
  const bf16*Qw=Q+(rowbase+q0+wid*QBLK)*DM+qkcol;
  const bf16*Kh=K+rowbase*DM+qkcol,*Vh=V+rowbase*DM+vcol;
  const unsigned lds0=(unsigned)(uintptr_t)shm;
  float*wsf=(float*)(shm+LDS_WS)+wid*64;
  const bf16*ksrc=Kh+(long)lane*DM+wid*8;
  const bf16*vsrc=Vh+(long)(16*(wid&3)+(lane>>2))*DM+(wid>>2)*32+(lane&3)*8;
  const unsigned kdst=lds0+LDS_K+wid*1024, vdst=lds0+LDS_V+wid*1024;
  #define DMA_K(t,slot) glds16(ksrc+(long)(t)*KVBLK*DM,(unsigned)__builtin_amdgcn_readfirstlane(kdst+(slot)))
  #define DMA_V(t,slot) glds16(vsrc+(long)(t)*KVBLK*DM,(unsigned)__builtin_amdgcn_readfirstlane(vdst+(slot)))
  const int vb0=(int)(lds0+LDS_V)+((lane>>4)&1)*32+(lane&3)*8+(4*hi+((lane&15)>>2))*64;
  const char*Kbase=shm+LDS_K; bf16x8 kf[8];
  const lds_cptr shm3=(lds_cptr)shm; const lds_cptr kp0=shm3+LDS_K+hi*1024+r32*16; const lds_cptr vp0=shm3+LDS_V+((lane>>4)&1)*32+(lane&3)*8+(4*hi+((lane&15)>>2))*64;
  const int NT=(q0+QB)/KVBLK;
  DMA_K(0,0);DMA_V(0,0);DMA_K(1,SLOTB);
  bf16x8 qr[4];
  #pragma unroll
  for(int d0=0;d0<4;++d0)qr[d0]=*reinterpret_cast<const bf16x8*>(&Qw[(long)r32*DM+d0*16+hi*8]);
  float mhat=0.f,l_reg=0.f;f32x16 o[2];o[0]=f32x16{};o[1]=f32x16{};f32x16 negm=f32x16{};asm volatile("":"+v"(negm));
  const int qrel=wid*QBLK+r32;
  #define CMASK(P0,P1,t) do{int jb_=(t)-(NT-4); if(jb_>=0)cmask(P0,P1,jb_,qrel,hi);}while(0)
  bool resc=false;
  #define START(P0,P1) do{ const float rm=rowmax(P0,P1); resc=false; \
    { const float dl=rm; mhat=fadd_s(mhat,dl); \
      _Pragma("unroll") for(int r=0;r<16;++r){P0[r]=fsub_s(P0[r],dl);P1[r]=fsub_s(P1[r],dl);} \
      _Pragma("unroll") for(int r=0;r<16;++r)negm[r]=-mhat; asm volatile("":"+v"(negm)); } \
    _Pragma("unroll") for(int r=0;r<16;++r)P0[r]=__builtin_amdgcn_exp2f(P0[r]); }while(0)
  #define RESC() do{ if(resc){ asm volatile("s_waitcnt lgkmcnt(0)":::"memory"); \
      _Pragma("unroll") for(int d_=0;d_<2;++d_) _Pragma("unroll") for(int r=0;r<16;++r)o[d_][r]*=wsf[crow(r,hi)]; } }while(0)
  f32x16 pA0,pA1,pB0,pB1;
  int sl_prev=0,sl_cur=0,sl_next=SLOTB;
  #define ROT() do{sl_prev=sl_cur;sl_cur=sl_next;sl_next=(sl_next==(NSLOT-1)*SLOTB)?0:sl_next+SLOTB;}while(0)
  DMA_K(2,2*SLOTB);
  WAIT_BAR(3);
  qkt(pA0,pA1,Kbase,qr,negm,r32,hi);asm volatile("s_nop 15\n\ts_nop 7":"+v"(pA0),"+v"(pA1));CMASK(pA0,pA1,0);
  START(pA0,pA1);
  _Pragma("unroll") for(int r=0;r<16;++r)pA1[r]=__builtin_amdgcn_exp2f(pA1[r]);
  WAIT_BAR(0);
  DMA_K(3,0);DMA_V(1,SLOTB);
  ROT();
  kload8(kf,kp0+sl_cur);
  WAIT_BAR(2);
  s16x4 vlo[8],vhi[8]; u32x4 pw0,pw1,pw2,pw3;
  #define PKW(P,B) cvtpk_s(P[B],P[B+1])
  #define PAF(k) __builtin_bit_cast(bf16x8,pw##k)
  #define VFR(i) (bf16x8){vlo[i][0],vlo[i][1],vlo[i][2],vlo[i][3],vhi[i][0],vhi[i][1],vhi[i][2],vhi[i][3]}
  #define PIN(x) asm volatile("":"+v"(x))
  #define MX3(a,b,c) __builtin_fmaxf(__builtin_fmaxf((a),(b)),(c))
  #define GAPA(MF,A0,A1,A2,A3,W0,W1,PW) do{ MF; sacc+=A0; sacc+=A1; sacc+=A2; sacc+=A3; PIN(sacc); W0; W1; PIN(PW); SBAR(); }while(0)
  #define EX(v) __builtin_amdgcn_exp2f(v)
  #define GAPB(MF,X,B) do{ MF; X[B]=EX(X[B]); X[B+1]=EX(X[B+1]); X[B+2]=EX(X[B+2]); X[B+3]=EX(X[B+3]); PIN(X); SBAR(); }while(0)
  #define VRD(i) do{ vlo[i]=vtr(vp_+(((i)>>2)*4096+((i)&3)*1024)); vhi[i]=vtr(vp_+(((i)>>2)*4096+((i)&3)*1024+512)); }while(0)
  #define KRD(G,j) do{ if(G){ kload2(kf,kp0+sl_next,j); SBAR(); } }while(0)
  #define STEP(C0,C1,P0,P1,t,GK,GV,GL) do{ SBAR(); \
    const lds_cptr vp_=vp0+sl_prev; \
    VRD(0); SBAR(); float sacc=(P0[0]+P0[1]); \
    GAPA(C0=__builtin_amdgcn_mfma_f32_32x32x16_bf16(kf[0],qr[0],negm,0,0,0), P0[2],P0[3],P0[4],P0[5],     pw0[0]=PKW(P0,0), pw0[1]=PKW(P0,2), pw0); \
    VRD(4); SBAR(); GAPA(C1=__builtin_amdgcn_mfma_f32_32x32x16_bf16(kf[1],qr[0],negm,0,0,0), P0[6],P0[7],P0[8],P0[9],     pw0[2]=PKW(P0,4), pw0[3]=PKW(P0,6), pw0); \
    VRD(1); SBAR(); GAPA(C0=__builtin_amdgcn_mfma_f32_32x32x16_bf16(kf[2],qr[1],C0,0,0,0),   P0[10],P0[11],P0[12],P0[13], pw1[0]=PKW(P0,8), pw1[1]=PKW(P0,10), pw1); \
    VRD(5); SBAR(); GAPA(C1=__builtin_amdgcn_mfma_f32_32x32x16_bf16(kf[3],qr[1],C1,0,0,0),   P0[14],P0[15],P1[0],P1[1],   pw1[2]=PKW(P0,12),pw1[3]=PKW(P0,14), pw1); \
    VRD(2); SBAR(); GAPA(C0=__builtin_amdgcn_mfma_f32_32x32x16_bf16(kf[4],qr[2],C0,0,0,0),   P1[2],P1[3],P1[4],P1[5],     pw2[0]=PKW(P1,0), pw2[1]=PKW(P1,2), pw2); \
    VRD(6); SBAR(); GAPA(C1=__builtin_amdgcn_mfma_f32_32x32x16_bf16(kf[5],qr[2],C1,0,0,0),   P1[6],P1[7],P1[8],P1[9],     pw2[2]=PKW(P1,4), pw2[3]=PKW(P1,6), pw2); \
    VRD(3); SBAR(); GAPA(C0=__builtin_amdgcn_mfma_f32_32x32x16_bf16(kf[6],qr[3],C0,0,0,0),   P1[10],P1[11],P1[12],P1[13], pw3[0]=PKW(P1,8), pw3[1]=PKW(P1,10), pw3); \
    VRD(7); SBAR(); GAPA(C1=__builtin_amdgcn_mfma_f32_32x32x16_bf16(kf[7],qr[3],C1,0,0,0),   P1[14],P1[15],0.f,0.f,       pw3[2]=PKW(P1,12),pw3[3]=PKW(P1,14), pw3); \
    l_reg+=sacc; \
    if(GK){DMA_K((t)+3,sl_cur);} if(GV){DMA_V((t)+1,sl_next);} \
    CMASK(C0,C1,t); \
    { float a=MX3(C0[0],C0[1],C1[0]),b=MX3(C0[2],C0[3],C1[1]); a=MX3(a,C1[2],C1[3]); \
      _Pragma("unroll") for(int r=4;r<16;r+=4){a=MX3(a,C0[r],C0[r+1]);b=MX3(b,C0[r+2],C0[r+3]);a=MX3(a,C1[r],C1[r+1]);b=MX3(b,C1[r+2],C1[r+3]);} \
      float rm=__builtin_fmaxf(a,b); { auto rr=__builtin_amdgcn_permlane32_swap(__float_as_uint(rm),__float_as_uint(rm),false,false); rm=__builtin_fmaxf(__uint_as_float(rr[0]),__uint_as_float(rr[1])); } \
      resc=false; \
      if(__builtin_expect(__any(rm>(float)THRL),0)){ const float dl=__builtin_fmaxf(rm,0.f); mhat+=dl; \
        _Pragma("unroll") for(int r=0;r<16;++r){C0[r]-=dl;C1[r]-=dl;} \
        _Pragma("unroll") for(int r=0;r<16;++r)negm[r]=-mhat; asm volatile("":"+v"(negm)); \
        const float f=__builtin_amdgcn_exp2f(-dl); l_reg*=f; if(hi==0)wsf[r32]=f; resc=true; } } \
    SBAR(); \
    GAPB(o[0]=__builtin_amdgcn_mfma_f32_32x32x16_bf16(PAF(0),VFR(0),o[0],0,0,0), C0,0); \
    GAPB(o[1]=__builtin_amdgcn_mfma_f32_32x32x16_bf16(PAF(0),VFR(4),o[1],0,0,0), C0,4); \
    KRD(GL,0); GAPB(o[0]=__builtin_amdgcn_mfma_f32_32x32x16_bf16(PAF(1),VFR(1),o[0],0,0,0), C0,8); \
    KRD(GL,1); GAPB(o[1]=__builtin_amdgcn_mfma_f32_32x32x16_bf16(PAF(1),VFR(5),o[1],0,0,0), C0,12); \
    KRD(GL,2); GAPB(o[0]=__builtin_amdgcn_mfma_f32_32x32x16_bf16(PAF(2),VFR(2),o[0],0,0,0), C1,0); \
    KRD(GL,3); GAPB(o[1]=__builtin_amdgcn_mfma_f32_32x32x16_bf16(PAF(2),VFR(6),o[1],0,0,0), C1,4); \
    GAPB(o[0]=__builtin_amdgcn_mfma_f32_32x32x16_bf16(PAF(3),VFR(3),o[0],0,0,0), C1,8); \
    GAPB(o[1]=__builtin_amdgcn_mfma_f32_32x32x16_bf16(PAF(3),VFR(7),o[1],0,0,0), C1,12); \
    }while(0)
  int t=1;
  #undef CMASK
  #define CMASK(P0,P1,t) do{}while(0)
  for(;t+5<NT;t+=2){
    STEP(pB0,pB1,pA0,pA1,t,true,true,true);     WAIT_BAR(2); RESC(); ROT();
    STEP(pA0,pA1,pB0,pB1,t+1,true,true,true);   WAIT_BAR(2); RESC(); ROT();
  }
  #undef CMASK
  #define CMASK(P0,P1,t) do{int jb_=(t)-(NT-4); if(jb_>=0)cmask(P0,P1,jb_,qrel,hi);}while(0)
  #define ENDW(tt) do{ if((tt)+3<NT){WAIT_BAR(2);} else if((tt)+2<NT){WAIT_BAR(1);} else {WAIT_BAR(0);} }while(0)
  for(;t+1<NT;t+=2){
    STEP(pB0,pB1,pA0,pA1,t,(t+3<NT),(t+1<NT),(t+1<NT));       ENDW(t);   RESC(); ROT();
    STEP(pA0,pA1,pB0,pB1,t+1,(t+4<NT),(t+2<NT),(t+2<NT));     ENDW(t+1); RESC(); ROT();
  }
  STEP(pB0,pB1,pA0,pA1,NT-1,false,false,false); RESC();
  { float sacc=pB0[0]+pB0[1]; _Pragma("unroll") for(int r=2;r<16;++r)sacc+=pB0[r]; _Pragma("unroll") for(int r=0;r<16;++r)sacc+=pB1[r]; l_reg+=sacc;
    pw0=(u32x4){PKW(pB0,0),PKW(pB0,2),PKW(pB0,4),PKW(pB0,6)};pw1=(u32x4){PKW(pB0,8),PKW(pB0,10),PKW(pB0,12),PKW(pB0,14)};pw2=(u32x4){PKW(pB1,0),PKW(pB1,2),PKW(pB1,4),PKW(pB1,6)};pw3=(u32x4){PKW(pB1,8),PKW(pB1,10),PKW(pB1,12),PKW(pB1,14)};
    SBAR(); pv(o,vb0+sl_cur,PAF(0),PAF(1),PAF(2),PAF(3)); }
  #undef PKW
  #undef PAF
  #undef VFR
  #undef PIN
  #undef MX3
  #undef GAPA
  #undef GAPB
  #undef EX
  #undef VRD
  #undef KRD
  #undef STEP
  #undef ENDW
  {auto rr=__builtin_amdgcn_permlane32_swap(__float_as_uint(l_reg),__float_as_uint(l_reg),false,false);l_reg=__uint_as_float(rr[0])+__uint_as_float(rr[1]);}
  if(hi==0)wsf[32+r32]=l_reg;asm volatile("s_waitcnt lgkmcnt(0)":::"memory");
  float rli[16];
  #pragma unroll
  for(int r=0;r<16;++r)rli[r]=__builtin_amdgcn_rcpf(wsf[32+crow(r,hi)]);
  bf16*Ow=O+(rowbase+q0+wid*QBLK)*DM+vcol;
  { bf16*stg=(bf16*)(shm+LDS_OST)+wid*2048;
    #pragma unroll
    for(int r=0;r<16;++r){const int orow=crow(r,hi);
      #pragma unroll
      for(int d0=0;d0<2;++d0)stg[orow*64+d0*32+r32]=__float2bfloat16(o[d0][r]*rli[r]);}
    asm volatile("s_waitcnt lgkmcnt(0)":::"memory");
    #pragma unroll
    for(int i=0;i<4;++i){const int row=i*8+(lane>>3),ch=lane&7; const u32x4 v=*(const u32x4*)(stg+row*64+ch*8); ATTN_STORE16(Ow+(long)row*DM+ch*8,v);} }
  asm volatile("s_waitcnt lgkmcnt(0)\n\ts_barrier":::"memory");
  #undef DMA_K
  #undef DMA_V
  #undef CMASK
  #undef START
  #undef RESC
  #undef ROT
}
constexpr int ATTN_LDS_BYTES=LDS_BYTES;
struct AttnTensors { const bf16* Q; const bf16* K; const bf16* V; bf16* O0; bf16* O1; };
struct AttnUnit { int bh; int qb; };
struct StaticOrder {
  int vcu;
  __device__ __forceinline__ explicit StaticOrder(int grid,int block):vcu((block%8)*(grid/8)+block/8){}
  __device__ __forceinline__ bool next(int i,AttnUnit&u)const{ if(i>=8)return false; const int s=vcu&7; u.bh=vcu; u.qb=(i+s)&7; return true; }
  __device__ __forceinline__ void a_ready(const AttnUnit&)const{}
  __device__ __forceinline__ void done(const AttnUnit&)const{}
};
template<class Sched,int THRL=8> __device__ __forceinline__ void attn_phase(char*lds,const AttnTensors&T,const Sched&S){
  AttnUnit u;
  for(int i=0;S.next(i,u);++i){ S.a_ready(u); { const int vh=u.bh&31,hh=vh>>2,cc=(vh>>1)&1,hf=vh&1; attn_unit<THRL>(u.bh>>5,(hh*2+cc)*64,hh*128+hf*64,u.qb,T.Q,T.K,T.V,cc?T.O1:T.O0,lds); } S.done(u); }
}
#undef SBAR
#undef WAIT_BAR
}

constexpr int NWAVES = 8;
constexpr int N_LAUNCHES = MK_N_LAUNCHES;
constexpr int NPHASE = 19;
constexpr int M = 16384, SEQ = 2048, D = 1024, NPROJ = 6144, RV = 2048, FF = 2816, FF2 = 5632;
constexpr float EPS = 1e-6f;
constexpr size_t MiB = 1u << 20;
constexpr size_t WS_CTL = 0, CTL_ZERO_BYTES = 1 * MiB;
constexpr size_t WS_COS = 1 * MiB, WS_SIN = 2 * MiB;
constexpr size_t WS_WA = 4 * MiB;
constexpr size_t WS_WB = 16 * MiB;
constexpr size_t WS_WC = 20 * MiB;
constexpr size_t WS_WD = 31 * MiB;
constexpr size_t WS_BIG = 37 * MiB;
constexpr size_t B_PROJ = WS_BIG;
constexpr size_t B_H = WS_BIG;
constexpr size_t B_UP = WS_BIG;
constexpr size_t B_XN = WS_BIG + 176 * MiB;
constexpr size_t B_SIDE = WS_BIG + 208 * MiB;
constexpr size_t B_XN2 = WS_BIG;
constexpr size_t B_QKV = WS_BIG + 32 * MiB;
constexpr size_t B_O0 = WS_BIG + 128 * MiB, B_O1 = WS_BIG + 160 * MiB;
constexpr size_t B_ON = WS_BIG;
constexpr size_t B_H2 = WS_BIG + 32 * MiB;
constexpr size_t WS_END = 256 * MiB;
static_assert(B_SIDE + (size_t)256 * 2 * FF * 2 <= WS_END && B_PROJ + (size_t)M * NPROJ * 2 <= WS_END && B_O1 + (size_t)M * D * 2 <= WS_END, "d_ws map");
constexpr int RING_OFF = 0, RING_BYTES = 131072;
constexpr int LDS_BYTES = 147456;

#define GAS __attribute__((address_space(1)))
#define LAS __attribute__((address_space(3)))
#define DI __device__ __forceinline__
typedef unsigned short bf16;
typedef unsigned v4u __attribute__((ext_vector_type(4)));
typedef unsigned v2u __attribute__((ext_vector_type(2)));
typedef float f32x4 __attribute__((ext_vector_type(4)));
typedef short bf16x8 __attribute__((ext_vector_type(8)));
typedef short v4i16 __attribute__((ext_vector_type(4)));
typedef float f32x2v __attribute__((ext_vector_type(2)));
typedef __bf16 bf16x2v __attribute__((ext_vector_type(2)));
#define LDS_WAIT() asm volatile("s_waitcnt lgkmcnt(0)" ::: "memory")

DI unsigned pk2(float lo, float hi) { f32x2v v = {lo, hi}; bf16x2v b = __builtin_convertvector(v, bf16x2v); return __builtin_bit_cast(unsigned, b); }
DI float bflo(unsigned w) { return __uint_as_float(w << 16); }
DI float bfhi(unsigned w) { return __uint_as_float(w & 0xffff0000u); }
DI float wave_sum(float v) {
#pragma unroll
    for (int o = 1; o < 64; o <<= 1) v += __shfl_xor(v, o);
    return v;
}

DI void transpose_item(const float* W, int K, int N, bf16* WT, int row_off, const float* gain, int kmod, float cs, LAS float* scr, int item, int lane) {
    const int nblk = N / 32, kb = item / nblk, nb = item % nblk, k0 = 64 * kb, n0 = 32 * nb;
#pragma unroll 8
    for (int i = 0; i < 32; ++i) { const int kk = 2 * i + (lane >> 5); float g = cs; if (gain) g *= gain[(k0 + kk) % kmod];
        scr[kk * 33 + (lane & 31)] = W[(size_t)(k0 + kk) * N + n0 + (lane & 31)] * g; }
    LDS_WAIT(); asm volatile("" ::: "memory");
    const int c = lane & 7;
#pragma unroll
    for (int j = 0; j < 4; ++j) { const int n = (lane >> 3) + 8 * j; const LAS float* s = scr + (8 * c) * 33 + n;
        v4u o; o.x = pk2(s[0 * 33], s[1 * 33]); o.y = pk2(s[2 * 33], s[3 * 33]); o.z = pk2(s[4 * 33], s[5 * 33]); o.w = pk2(s[6 * 33], s[7 * 33]);
        *(v4u*)(WT + (size_t)(row_off + n0 + n) * K + k0 + 8 * c) = o; }
    LDS_WAIT(); asm volatile("" ::: "memory");
}
DI void convert_matrix(const float* W, int K, int N, bf16* WT, int row_off, const float* gain, int kmod, float cs, LAS unsigned char* lds, int gw, int NGW, int wave, int lane) {
    LAS float* scr = (LAS float*)(lds + RING_OFF + wave * 16384);
    const int nitems = (K / 64) * (N / 32);
    for (int it = gw; it < nitems; it += NGW) transpose_item(W, K, N, WT, row_off, gain, kmod, cs, scr, it, lane);
}

DI void norm_rows(const float* x, bf16* xn, int gw, int NGW, int lane) {
    for (int m = gw; m < M; m += NGW) {
        const f32x4* xr = (const f32x4*)(x + (size_t)m * D) + lane;
        f32x4 v[4]; float s = 0.f;
#pragma unroll
        for (int j = 0; j < 4; ++j) { v[j] = xr[64 * j]; s += (v[j].x * v[j].x + v[j].y * v[j].y) + (v[j].z * v[j].z + v[j].w * v[j].w); }
        const float rstd = 1.0f / sqrtf(wave_sum(s) * (1.f / D) + EPS);
        v2u* o8 = (v2u*)(xn + (size_t)m * D) + lane;
#pragma unroll
        for (int j = 0; j < 4; ++j) { v2u w; w.x = pk2(v[j].x * rstd, v[j].y * rstd); w.y = pk2(v[j].z * rstd, v[j].w * rstd); o8[64 * j] = w; }
    }
}
DI void resid_rows(const bf16* h, const float* base, const float* gain, float* xo, bf16* xn, int gw, int NGW, int lane) {
    f32x4 gv[4];
#pragma unroll
    for (int j = 0; j < 4; ++j) gv[j] = ((const f32x4*)gain)[lane + 64 * j];
    for (int m = gw; m < M; m += NGW) {
        const v2u* hr = (const v2u*)(h + (size_t)m * D) + lane;
        const f32x4* br = (const f32x4*)(base + (size_t)m * D) + lane;
        f32x4 hv[4], bv[4]; float s = 0.f;
#pragma unroll
        for (int j = 0; j < 4; ++j) { const v2u w = hr[64 * j]; hv[j] = (f32x4){bflo(w.x), bfhi(w.x), bflo(w.y), bfhi(w.y)}; bv[j] = br[64 * j];
            s += (hv[j].x * hv[j].x + hv[j].y * hv[j].y) + (hv[j].z * hv[j].z + hv[j].w * hv[j].w); }
        const float rstd = 1.0f / sqrtf(wave_sum(s) * (1.f / D) + EPS);
        float s2 = 0.f;
#pragma unroll
        for (int j = 0; j < 4; ++j) { hv[j] = bv[j] + hv[j] * rstd * gv[j]; s2 += (hv[j].x * hv[j].x + hv[j].y * hv[j].y) + (hv[j].z * hv[j].z + hv[j].w * hv[j].w); }
        f32x4* orow = (f32x4*)(xo + (size_t)m * D) + lane;
#pragma unroll
        for (int j = 0; j < 4; ++j) orow[64 * j] = hv[j];
        if (xn) {
            const float r2 = 1.0f / sqrtf(wave_sum(s2) * (1.f / D) + EPS);
            v2u* o8 = (v2u*)(xn + (size_t)m * D) + lane;
#pragma unroll
            for (int j = 0; j < 4; ++j) { v2u w; w.x = pk2(hv[j].x * r2, hv[j].y * r2); w.y = pk2(hv[j].z * r2, hv[j].w * r2); o8[64 * j] = w; }
        }
    }
}
DI void y_rows(bf16* outraw, const bf16* proj, int gw, int NGW, int lane) {
    for (int m = gw; m < M; m += NGW) {
#pragma unroll
        for (int hh = 0; hh < 4; ++hh) {
            v4u* op = (v4u*)(outraw + (size_t)m * RV + hh * 512) + lane;
            const v4u ov = *op; const v4u gvv = *((const v4u*)(proj + (size_t)m * NPROJ + 4096 + hh * 512) + lane);
            float o[8] = {bflo(ov.x), bfhi(ov.x), bflo(ov.y), bfhi(ov.y), bflo(ov.z), bfhi(ov.z), bflo(ov.w), bfhi(ov.w)};
            float g[8] = {bflo(gvv.x), bfhi(gvv.x), bflo(gvv.y), bfhi(gvv.y), bflo(gvv.z), bfhi(gvv.z), bflo(gvv.w), bfhi(gvv.w)};
            float s = 0.f;
#pragma unroll
            for (int e = 0; e < 8; ++e) s += o[e] * o[e];
            const float rstd = 1.0f / sqrtf(wave_sum(s) * (1.f / 512.f) + EPS);
            v4u w; w.x = pk2(o[0] * rstd * g[0], o[1] * rstd * g[1]); w.y = pk2(o[2] * rstd * g[2], o[3] * rstd * g[3]);
            w.z = pk2(o[4] * rstd * g[4], o[5] * rstd * g[5]); w.w = pk2(o[6] * rstd * g[6], o[7] * rstd * g[7]);
            *op = w;
        }
    }
}
DI void combine_rows(const bf16* O0, const bf16* O1, const float* lamp, float lambda_init, bf16* on, int gw, int NGW, int lane) {
    const float a = lamp[lane] * lamp[64 + lane], b = lamp[128 + lane] * lamp[192 + lane];
    const float lam = expf(wave_sum(a)) - expf(wave_sum(b)) + lambda_init;
    for (int m = gw; m < M; m += NGW) {
        const v4u* p0 = (const v4u*)(O0 + (size_t)m * D) + 2 * lane; const v4u* p1 = (const v4u*)(O1 + (size_t)m * D) + 2 * lane;
        const v4u a0 = p0[0], a1 = p0[1], b0 = p1[0], b1 = p1[1];
        const unsigned aw[8] = {a0.x, a0.y, a0.z, a0.w, a1.x, a1.y, a1.z, a1.w}, bw[8] = {b0.x, b0.y, b0.z, b0.w, b1.x, b1.y, b1.z, b1.w};
        float o[16]; float s = 0.f;
#pragma unroll
        for (int e = 0; e < 8; ++e) { o[2 * e] = bflo(aw[e]) - lam * bflo(bw[e]); o[2 * e + 1] = bfhi(aw[e]) - lam * bfhi(bw[e]); s += o[2 * e] * o[2 * e] + o[2 * e + 1] * o[2 * e + 1]; }
        s += __shfl_xor(s, 1); s += __shfl_xor(s, 2); s += __shfl_xor(s, 4);
        const float rstd = 1.0f / sqrtf(s * (1.f / 128.f) + EPS);
        v4u w0, w1; w0.x = pk2(o[0] * rstd, o[1] * rstd); w0.y = pk2(o[2] * rstd, o[3] * rstd); w0.z = pk2(o[4] * rstd, o[5] * rstd); w0.w = pk2(o[6] * rstd, o[7] * rstd);
        w1.x = pk2(o[8] * rstd, o[9] * rstd); w1.y = pk2(o[10] * rstd, o[11] * rstd); w1.z = pk2(o[12] * rstd, o[13] * rstd); w1.w = pk2(o[14] * rstd, o[15] * rstd);
        v4u* op = (v4u*)(on + (size_t)m * D) + 2 * lane; op[0] = w0; op[1] = w1;
    }
}
DI void conv_rows(bf16* up, const bf16* side, const float* cw, const float* cb, int G, int vb, int tid) {
    if (tid >= FF / 8) return;
    const int c0 = tid * 8;
    float wg[3][8], wu[3][8], bg[8], bu[8];
#pragma unroll
    for (int j = 0; j < 3; ++j)
#pragma unroll
        for (int e = 0; e < 8; ++e) { wg[j][e] = cw[j * FF2 + c0 + e]; wu[j][e] = cw[j * FF2 + FF + c0 + e]; }
#pragma unroll
    for (int e = 0; e < 8; ++e) { bg[e] = cb[c0 + e]; bu[e] = cb[FF + c0 + e]; }
    for (int blk = vb; blk < M / 64; blk += G) {
        const int t0 = blk * 64;
        float g2[8], g1[8], u2[8], u1[8];
        if ((t0 & (SEQ - 1)) == 0) {
#pragma unroll
            for (int e = 0; e < 8; ++e) { g2[e] = 0.f; g1[e] = 0.f; u2[e] = 0.f; u1[e] = 0.f; }
        } else {
            const v4u a = *(const v4u*)(side + (size_t)((blk - 1) * 2 + 0) * FF + c0), b = *(const v4u*)(side + (size_t)((blk - 1) * 2 + 1) * FF + c0);
            const v4u c = *(const v4u*)(up + (size_t)(t0 - 2) * FF2 + FF + c0), d = *(const v4u*)(up + (size_t)(t0 - 1) * FF2 + FF + c0);
            const unsigned aw[4] = {a.x, a.y, a.z, a.w}, bw[4] = {b.x, b.y, b.z, b.w}, cw4[4] = {c.x, c.y, c.z, c.w}, dw[4] = {d.x, d.y, d.z, d.w};
#pragma unroll
            for (int e = 0; e < 4; ++e) { g2[2 * e] = bflo(aw[e]); g2[2 * e + 1] = bfhi(aw[e]); g1[2 * e] = bflo(bw[e]); g1[2 * e + 1] = bfhi(bw[e]);
                u2[2 * e] = bflo(cw4[e]); u2[2 * e + 1] = bfhi(cw4[e]); u1[2 * e] = bflo(dw[e]); u1[2 * e + 1] = bfhi(dw[e]); }
        }
        for (int t = t0; t < t0 + 64; t += 4) {
            v4u gr[4], ur[4];
#pragma unroll
            for (int i = 0; i < 4; ++i) { gr[i] = *(const v4u*)(up + (size_t)(t + i) * FF2 + c0); ur[i] = *(const v4u*)(up + (size_t)(t + i) * FF2 + FF + c0); }
#pragma unroll
            for (int i = 0; i < 4; ++i) {
                const unsigned gw4[4] = {gr[i].x, gr[i].y, gr[i].z, gr[i].w}, uw4[4] = {ur[i].x, ur[i].y, ur[i].z, ur[i].w};
                float gc[8], uc[8], act[8];
#pragma unroll
                for (int e = 0; e < 4; ++e) { gc[2 * e] = bflo(gw4[e]); gc[2 * e + 1] = bfhi(gw4[e]); uc[2 * e] = bflo(uw4[e]); uc[2 * e + 1] = bfhi(uw4[e]); }
#pragma unroll
                for (int e = 0; e < 8; ++e) {
                    const float hg = bg[e] + wg[0][e] * g2[e] + wg[1][e] * g1[e] + wg[2][e] * gc[e];
                    const float hu = bu[e] + wu[0][e] * u2[e] + wu[1][e] * u1[e] + wu[2][e] * uc[e];
                    act[e] = hg * __builtin_amdgcn_rcpf(1.0f + __expf(-hg)) * hu;
                    g2[e] = g1[e]; g1[e] = gc[e]; u2[e] = u1[e]; u1[e] = uc[e];
                }
                v4u w; w.x = pk2(act[0], act[1]); w.y = pk2(act[2], act[3]); w.z = pk2(act[4], act[5]); w.w = pk2(act[6], act[7]);
                *(v4u*)(up + (size_t)(t + i) * FF2 + c0) = w;
            }
        }
    }
}

DI bf16x8 tr_frag(LAS const unsigned char* lo, int hi_off) {
    const v4i16 a = __builtin_amdgcn_ds_read_tr16_b64_v4i16((LAS v4i16*)lo);
    const v4i16 b = __builtin_amdgcn_ds_read_tr16_b64_v4i16((LAS v4i16*)(lo + hi_off));
    return (bf16x8){a[0], a[1], a[2], a[3], b[0], b[1], b[2], b[3]};
}
#define MFMA16(a, b, c) __builtin_amdgcn_mfma_f32_16x16x32_bf16((a), (b), (c), 0, 0, 0)
DI void retention_phase(LAS unsigned char* lds, const bf16* proj, bf16* outraw, int G, int vcu) {
    const int tid = threadIdx.x, lane = tid & 63, wid = __builtin_amdgcn_readfirstlane(tid >> 6);
    const int fr = lane & 15, fq = lane >> 4, q = fr >> 2, p = fr & 3;
    const int rb = wid < 4 ? wid : 11 - wid;
    constexpr int KROW = 528, VROW = 144, SROW = 144;
    constexpr int KS_OFF = 0, VS_OFF = 128 * KROW, SS_OFF = VS_OFF + 128 * VROW;
    static_assert(SS_OFF + 256 * SROW <= RING_BYTES, "retention LDS");
    LAS unsigned char* KS = lds + KS_OFF; LAS unsigned char* VS = lds + VS_OFF; LAS unsigned char* SS = lds + SS_OFF;
    for (int item = vcu; item < 256; item += G) {
        const int b = item >> 5, h = (item >> 3) & 3, es = item & 7;
        const float l2g = log2f(1.0f - exp2f(-5.0f - (float)h));
        const float cd = exp2f(l2g * 128.0f);
        for (int i = tid; i < 256 * SROW / 4; i += NWAVES * 64) ((LAS unsigned*)SS)[i] = 0u;
        f32x4 st[2][4];
#pragma unroll
        for (int mi = 0; mi < 2; ++mi)
#pragma unroll
            for (int nb = 0; nb < 4; ++nb) st[mi][nb] = (f32x4){0.f, 0.f, 0.f, 0.f};
        const bf16* Qg = proj + (size_t)(b * SEQ) * NPROJ + h * 256;
        const bf16* Kg = Qg + 1024;
        const bf16* Vg = proj + (size_t)(b * SEQ) * NPROJ + 2048 + h * 512 + es * 64;
        bf16* Og = outraw + (size_t)(b * SEQ) * RV + h * 512 + es * 64;
        for (int c = 0; c < 16; ++c) {
#pragma unroll
            for (int i = 0; i < 8; ++i) { const int pc = tid + 512 * i, row = pc >> 5, c16 = pc & 31;
                const v4u v = *(const v4u*)(Kg + (size_t)(c * 128 + row) * NPROJ + c16 * 8);
                *(LAS v4u*)(KS + row * KROW + c16 * 16) = v; }
#pragma unroll
            for (int i = 0; i < 2; ++i) { const int pc = tid + 512 * i, row = pc >> 3, c16 = pc & 7;
                const v4u v = *(const v4u*)(Vg + (size_t)(c * 128 + row) * NPROJ + c16 * 8);
                const float kd = exp2f(l2g * (float)(127 - row));
                v4u w; w.x = pk2(bflo(v.x) * kd, bfhi(v.x) * kd); w.y = pk2(bflo(v.y) * kd, bfhi(v.y) * kd); w.z = pk2(bflo(v.z) * kd, bfhi(v.z) * kd); w.w = pk2(bflo(v.w) * kd, bfhi(v.w) * kd);
                *(LAS v4u*)(VS + row * VROW + c16 * 16) = w; }
            bf16x8 Qf[8];
#pragma unroll
            for (int ks = 0; ks < 8; ++ks) Qf[ks] = *(const bf16x8*)(Qg + (size_t)(c * 128 + 16 * rb + fr) * NPROJ + ks * 32 + fq * 8);
            __syncthreads();
            f32x4 ao[4];
#pragma unroll
            for (int nb = 0; nb < 4; ++nb) ao[nb] = (f32x4){0.f, 0.f, 0.f, 0.f};
#pragma unroll
            for (int ks = 0; ks < 8; ++ks)
#pragma unroll
                for (int nb = 0; nb < 4; ++nb) { const bf16x8 B = tr_frag(SS + (32 * ks + 8 * fq + q) * SROW + (16 * nb + 4 * p) * 2, 4 * SROW); ao[nb] = MFMA16(Qf[ks], B, ao[nb]); }
#pragma unroll
            for (int kp = 0; kp < 4; ++kp) {
                if (2 * kp <= rb) {
                    f32x4 s0 = (f32x4){0.f, 0.f, 0.f, 0.f}, s1 = (f32x4){0.f, 0.f, 0.f, 0.f};
#pragma unroll
                    for (int ks = 0; ks < 8; ++ks) { const bf16x8 A = *(const LAS bf16x8*)(KS + (32 * kp + fr) * KROW + (32 * ks + 8 * fq) * 2); s0 = MFMA16(A, Qf[ks], s0); }
                    if (2 * kp == rb) {
#pragma unroll
                        for (int jj = 0; jj < 4; ++jj) if (4 * fq + jj > fr) s0[jj] = 0.f;
                    }
                    if (2 * kp + 1 <= rb) {
#pragma unroll
                        for (int ks = 0; ks < 8; ++ks) { const bf16x8 A = *(const LAS bf16x8*)(KS + (32 * kp + 16 + fr) * KROW + (32 * ks + 8 * fq) * 2); s1 = MFMA16(A, Qf[ks], s1); }
                        if (2 * kp + 1 == rb) {
#pragma unroll
                            for (int jj = 0; jj < 4; ++jj) if (4 * fq + jj > fr) s1[jj] = 0.f;
                        }
                    }
                    v4u pw; pw.x = pk2(s0[0], s0[1]); pw.y = pk2(s0[2], s0[3]); pw.z = pk2(s1[0], s1[1]); pw.w = pk2(s1[2], s1[3]);
                    const bf16x8 Pa = __builtin_bit_cast(bf16x8, pw);
#pragma unroll
                    for (int nb = 0; nb < 4; ++nb) { const bf16x8 B = tr_frag(VS + (32 * kp + 4 * fq + q) * VROW + (16 * nb + 4 * p) * 2, 16 * VROW); ao[nb] = MFMA16(Pa, B, ao[nb]); }
                }
            }
#pragma unroll
            for (int jj = 0; jj < 4; ++jj) { const int il = 16 * rb + 4 * fq + jj; const float sc = exp2f(l2g * (float)(il - 127));
                bf16* orow = Og + (size_t)(c * 128 + il) * RV + fr;
#pragma unroll
                for (int nb = 0; nb < 4; ++nb) orow[16 * nb] = (bf16)(pk2(ao[nb][jj] * sc, 0.f) & 0xffffu); }
#pragma unroll
            for (int mi = 0; mi < 2; ++mi)
#pragma unroll
                for (int nb = 0; nb < 4; ++nb) st[mi][nb] = st[mi][nb] * cd;
#pragma unroll
            for (int ks = 0; ks < 4; ++ks) {
                bf16x8 A[2], B[4];
#pragma unroll
                for (int mi = 0; mi < 2; ++mi) A[mi] = tr_frag(KS + (32 * ks + 8 * fq + q) * KROW + (16 * (2 * wid + mi) + 4 * p) * 2, 4 * KROW);
#pragma unroll
                for (int nb = 0; nb < 4; ++nb) B[nb] = tr_frag(VS + (32 * ks + 8 * fq + q) * VROW + (16 * nb + 4 * p) * 2, 4 * VROW);
#pragma unroll
                for (int mi = 0; mi < 2; ++mi)
#pragma unroll
                    for (int nb = 0; nb < 4; ++nb) st[mi][nb] = MFMA16(A[mi], B[nb], st[mi][nb]);
            }
            __syncthreads();
            if (c < 15) {
#pragma unroll
                for (int mi = 0; mi < 2; ++mi)
#pragma unroll
                    for (int nb = 0; nb < 4; ++nb)
#pragma unroll
                        for (int jj = 0; jj < 4; ++jj)
                            *(LAS unsigned short*)(SS + (16 * (2 * wid + mi) + 4 * fq + jj) * SROW + (16 * nb + fr) * 2) = (unsigned short)(pk2(st[mi][nb][jj] * cd, 0.f) & 0xffffu);
            }
        }
    }
}

typedef GAS unsigned gu32;
#define RLX_AGENT __ATOMIC_RELAXED, __HIP_MEMORY_SCOPE_AGENT
#define XB_TMO      128
#define XB_XCNT(j)  (256  + 64 * (j))
#define XB_XSUB(j)  (1280 + 64 * (j))
#define XB_XGEN(j)  (2304 + 64 * (j))
#define XB_TOP      3328
#define XB_TOPGEN   3392
#define XCD_BAR_WORDS 3456
#define XB_SPIN_CAP (1u << 18)

__device__ __forceinline__ unsigned xb_ld(unsigned* p)              { return __hip_atomic_load(p, __ATOMIC_RELAXED, __HIP_MEMORY_SCOPE_AGENT); }
__device__ __forceinline__ unsigned xb_add(unsigned* p, unsigned v) { return __hip_atomic_fetch_add(p, v, __ATOMIC_RELAXED, __HIP_MEMORY_SCOPE_AGENT); }
__device__ __forceinline__ unsigned xb_xcc_id() { return (unsigned)__builtin_amdgcn_s_getreg((3 << 11) | 20) & 0xFu; }
#define XB_SPIN(cond, bar) do { unsigned _sp = 0; while (cond) { __builtin_amdgcn_s_sleep(1); \
    if ((++_sp & 255u) == 0u) { if (xb_ld(&(bar)[XB_TMO])) break; if (_sp > XB_SPIN_CAP) { atomicAdd(&(bar)[XB_TMO], 1u); break; } } } } while (0)

struct XcdBarrier {
    unsigned* bar; unsigned x;
    volatile LAS unsigned* st;
};

__device__ __forceinline__ XcdBarrier xcd_barrier_post(unsigned* bar, volatile LAS unsigned* st) {
    XcdBarrier b; b.bar = bar; b.x = xb_xcc_id(); b.st = st;
    if (threadIdx.x == 0) (void)xb_add(&bar[XB_XCNT(b.x)], 1u);
    return b;
}
__device__ __forceinline__ void xcd_barrier_complete(unsigned* bar, unsigned x, unsigned& nloc, unsigned& nx) {
    const unsigned G = gridDim.x * gridDim.y * gridDim.z;
    unsigned sum, cnt, mine, sp = 0u;
    for (;;) {
        sum = 0u; cnt = 0u; mine = 0u;
#pragma unroll
        for (unsigned j = 0; j < 16; ++j) { const unsigned c = xb_ld(&bar[XB_XCNT(j)]); sum += c; cnt += (c > 0u) ? 1u : 0u; mine = (j == x) ? c : mine; }
        if (sum == G) break;
        __builtin_amdgcn_s_sleep(1);
        if ((++sp & 255u) == 0u) { if (xb_ld(&bar[XB_TMO])) break; if (sp > XB_SPIN_CAP) { atomicAdd(&bar[XB_TMO], 1u); break; } }
    }
    nloc = mine > 0u ? mine : 1u; nx = cnt > 0u ? cnt : 1u;
}

__device__ __forceinline__ void xcd_barrier(const XcdBarrier& b) {
    asm volatile("s_waitcnt vmcnt(0)" ::: "memory");
    __syncthreads();
    if (threadIdx.x == 0) {
        unsigned* bar = b.bar;
        __builtin_amdgcn_s_waitcnt(0);
        unsigned nloc = b.st[0], nx = b.st[1];
        if (nloc == 0u) { xcd_barrier_complete(bar, b.x, nloc, nx); b.st[0] = nloc; b.st[1] = nx; }
        const unsigned old = xb_add(&bar[XB_XSUB(b.x)], 1u);
        const unsigned gen = old / nloc;
        if (old + 1u == (gen + 1u) * nloc) {
            __builtin_amdgcn_fence(__ATOMIC_RELEASE, "agent");
            asm volatile("s_waitcnt vmcnt(0)" ::: "memory");
            const unsigned og = xb_add(&bar[XB_TOP], 1u);
            const unsigned tg = og / nx;
            if (og + 1u == (tg + 1u) * nx) xb_add(&bar[XB_TOPGEN], 1u);
            else XB_SPIN(xb_ld(&bar[XB_TOPGEN]) == tg, bar);
            __builtin_amdgcn_fence(__ATOMIC_ACQUIRE, "agent");
            xb_add(&bar[XB_XGEN(b.x)], 1u);
            asm volatile("s_waitcnt vmcnt(0)" ::: "memory");
        } else {
            XB_SPIN(xb_ld(&bar[XB_XGEN(b.x)]) == gen, bar);
            __builtin_amdgcn_fence(__ATOMIC_ACQUIRE, "agent");
            asm volatile("s_waitcnt vmcnt(0)" ::: "memory");
        }
    }
    __syncthreads();
}
constexpr int CW_BAR = 4096, MISC_OFF = RING_BYTES + 512;
constexpr int PTR_OFF = RING_BYTES + 1024;
DI const float* inptr(LAS unsigned char* lds, int k) {
    volatile LAS unsigned* t = (volatile LAS unsigned*)(lds + PTR_OFF);
    const unsigned lo = __builtin_amdgcn_readfirstlane(t[2 * k]), hi = __builtin_amdgcn_readfirstlane(t[2 * k + 1]);
    return (const float*)(((unsigned long long)hi << 32) | (unsigned long long)lo);
}
#define PH_IDS int tid = threadIdx.x; asm volatile("" : "+v"(tid)); const int lane = tid & 63, wave = __builtin_amdgcn_readfirstlane(tid >> 6); \
    const int gw = vcu * NWAVES + wave, NGW = G * NWAVES; (void)lane; (void)gw; (void)NGW;
#define WPTR(off) ((bf16*)(ws + (off)))

#define FFN_PHASES(L, pb) \
        if (IN(pb)) { \
            pg8::Gemm g{(const bf16*)(ws + B_XN), WPTR(WS_WC), M, FF2, D, D}; pg8::StaticOrder S; S.init(M, FF2, G, bx); \
            pg8::EpiOut E{(bf16*)(ws + B_UP), FF2, 0, 0, 1.f, (bf16*)(ws + B_SIDE), FF / 256, FF}; \
            pg8::gemm_phase<pg8::EpiOut, pg8::StaticOrder, true, true>(lds + RING_OFF, g, S, E); \
        } \
        SEAM(pb); \
        if (IN(pb + 1)) { PH_IDS \
            conv_rows((bf16*)(ws + B_UP), (const bf16*)(ws + B_SIDE), inptr(lds, 16) + (size_t)L * 3 * FF2, inptr(lds, 17) + (size_t)L * FF2, G, vcu, tid); \
            if (L == 0) convert_matrix(inptr(lds, 15) + (size_t)D * FF2, D, FF2, WPTR(WS_WC), 0, inptr(lds, 13) + D, D, 1.f, lds, gw, NGW, wave, lane); \
            __syncthreads(); \
        } \
        SEAM(pb + 1); \
        if (IN(pb + 2)) { \
            pg8::Gemm g{(const bf16*)(ws + B_UP), WPTR(WS_WD), M, D, FF, FF2}; pg8::StaticOrder S; S.init(M, D, G, bx); \
            pg8::EpiOut E{(bf16*)(ws + B_XN), D, 0, 0, 1.f, nullptr, 0, 0}; \
            pg8::gemm_phase<pg8::EpiOut, pg8::StaticOrder, true, true>(lds + RING_OFF, g, S, E); \
        } \
        SEAM(pb + 2); \
        if (IN(pb + 3)) { PH_IDS \
            resid_rows((const bf16*)(ws + B_XN), out, inptr(lds, 14) + (size_t)L * D, out, L == 0 ? (bf16*)(ws + B_XN2) : (bf16*)nullptr, gw, NGW, lane); \
            if (L == 0) convert_matrix(inptr(lds, 18) + (size_t)FF * D, FF, D, WPTR(WS_WD), 0, nullptr, FF, 1.f, lds, gw, NGW, wave, lane); \
            __syncthreads(); \
        }
struct Args { const float* in[19]; float* out; unsigned char* ws; int ph_lo, ph_hi; float lambda_init; int pad; };
__global__ void __launch_bounds__(NWAVES * 64, 2) yoco_fwd(Args args) {
    extern __shared__ __attribute__((aligned(16))) unsigned char lds_raw[];
    LAS unsigned char* lds = (LAS unsigned char*)lds_raw;
    cg::grid_group grid = cg::this_grid();
    const int G = gridDim.x; const int bx = blockIdx.x;
    const int vcu = (G % 8 == 0) ? (bx % 8) * (G / 8) + bx / 8 : bx;
    unsigned char* ws = args.ws;
    float* out = args.out;
    const int lo = args.ph_lo, hi = args.ph_hi;
    { const int t0 = threadIdx.x; if (t0 < 19) ((LAS unsigned long long*)(lds + PTR_OFF))[t0] = (unsigned long long)args.in[t0]; }
    if (threadIdx.x < 2) ((volatile LAS unsigned*)(lds + MISC_OFF))[threadIdx.x] = 0u;
    __syncthreads();
    XcdBarrier xbar; xbar.bar = (unsigned*)(ws + WS_CTL) + CW_BAR; xbar.x = 0; xbar.st = nullptr;
    if (N_LAUNCHES == 1) xbar = xcd_barrier_post((unsigned*)(ws + WS_CTL) + CW_BAR, (volatile LAS unsigned*)(lds + MISC_OFF));
#ifndef PHMASK
#define PHMASK 0x7ffff
#endif
#define IN(k) (((PHMASK >> ((k) > 14 ? (k) - 9 : (k))) & 1) && lo <= (k) && (k) < hi)
#define SEAM(k) do { if (IN(k) && IN((k) + 1)) { if ((k) == 0) grid.sync(); else xcd_barrier(xbar); } } while (0)

    if (IN(0)) { PH_IDS
        float* cosT = (float*)(ws + WS_COS); float* sinT = (float*)(ws + WS_SIN);
        for (int i = (vcu * NWAVES * 64 + tid); i < SEQ * 128; i += G * NWAVES * 64) { const int pos = i >> 7, j = i & 127;
            const float inv = 1.0f / exp2f(13.287712379549449f * ((float)j / 127.0f)); const float ang = (float)pos * inv;
            const double rev = (double)ang * 0.15915494309189535; const float fr = (float)(rev - floor(rev));
            cosT[i] = __builtin_amdgcn_cosf(fr); sinT[i] = __builtin_amdgcn_sinf(fr); }
        convert_matrix(inptr(lds, 3), D, NPROJ, WPTR(WS_WA), 0, inptr(lds, 1), D, 1.f, lds, gw, NGW, wave, lane);
        convert_matrix(inptr(lds, 4), RV, D, WPTR(WS_WB), 0, nullptr, RV, 1.f, lds, gw, NGW, wave, lane);
        convert_matrix(inptr(lds, 15), D, FF2, WPTR(WS_WC), 0, inptr(lds, 13), D, 1.f, lds, gw, NGW, wave, lane);
        convert_matrix(inptr(lds, 18), FF, D, WPTR(WS_WD), 0, nullptr, FF, 1.f, lds, gw, NGW, wave, lane);
        norm_rows(inptr(lds, 0), (bf16*)out, gw, NGW, lane);
        __syncthreads();
    }
    SEAM(0);
    if (IN(1)) {
        pg8::Gemm g{(const bf16*)out, WPTR(WS_WA), M, NPROJ, D, D}; pg8::StaticOrder S; S.init(M, NPROJ, G, bx);
        pg8::EpiProj E{(bf16*)(ws + B_PROJ), NPROJ, (const float*)(ws + WS_COS), (const float*)(ws + WS_SIN)};
        pg8::gemm_phase<pg8::EpiProj, pg8::StaticOrder, true, true>(lds + RING_OFF, g, S, E);
    }
    SEAM(1);
    if (IN(2)) { retention_phase(lds + RING_OFF, (const bf16*)(ws + B_PROJ), (bf16*)out, G, vcu); __syncthreads(); }
    SEAM(2);
    if (IN(3)) { PH_IDS
        y_rows((bf16*)out, (const bf16*)(ws + B_PROJ), gw, NGW, lane);
        convert_matrix(inptr(lds, 9), D, D, WPTR(WS_WA), 0, inptr(lds, 7), D, 1.f, lds, gw, NGW, wave, lane);
        convert_matrix(inptr(lds, 6), D, 2 * D, WPTR(WS_WA), D, inptr(lds, 5), D, 1.f, lds, gw, NGW, wave, lane);
        convert_matrix(inptr(lds, 12), D, D, WPTR(WS_WA + 8 * MiB), 0, inptr(lds, 11), 128, 1.0f - args.lambda_init, lds, gw, NGW, wave, lane);
        __syncthreads();
    }
    SEAM(3);
    if (IN(4)) {
        pg8::Gemm g{(const bf16*)out, WPTR(WS_WB), M, D, RV, RV}; pg8::StaticOrder S; S.init(M, D, G, bx);
        pg8::EpiOut E{(bf16*)(ws + B_H), D, 0, 0, 1.f, nullptr, 0, 0};
        pg8::gemm_phase<pg8::EpiOut, pg8::StaticOrder, true, true>(lds + RING_OFF, g, S, E);
    }
    SEAM(4);
    if (IN(5)) { PH_IDS resid_rows((const bf16*)(ws + B_H), inptr(lds, 0), inptr(lds, 2), out, (bf16*)(ws + B_XN), gw, NGW, lane); }
    SEAM(5);
    FFN_PHASES(0, 6)
    SEAM(9);
    if (IN(10)) {
        pg8::Gemm g{(const bf16*)(ws + B_XN2), WPTR(WS_WA), M, 3 * D, D, D}; pg8::StaticOrder S; S.init(M, 3 * D, G, bx);
        pg8::EpiOut E{(bf16*)(ws + B_QKV), D, D, (size_t)M * D, attn_body::C2, nullptr, 0, 0};
        pg8::gemm_phase<pg8::EpiOut, pg8::StaticOrder, true, true>(lds + RING_OFF, g, S, E);
    }
    SEAM(10);
    if (IN(11)) {
        const attn_body::bf16* Qp = (const attn_body::bf16*)(ws + B_QKV);
        const attn_body::AttnTensors AT{Qp, Qp + (size_t)M * D, Qp + (size_t)2 * M * D, (attn_body::bf16*)(ws + B_O0), (attn_body::bf16*)(ws + B_O1)};
        const attn_body::StaticOrder S((int)G, (int)bx);
        attn_body::attn_phase<attn_body::StaticOrder>((char*)lds_raw + RING_OFF, AT, S);
        __syncthreads();
    }
    SEAM(11);
    if (IN(12)) { PH_IDS combine_rows((const bf16*)(ws + B_O0), (const bf16*)(ws + B_O1), inptr(lds, 10), args.lambda_init, (bf16*)(ws + B_ON), gw, NGW, lane); }
    SEAM(12);
    if (IN(13)) {
        pg8::Gemm g{(const bf16*)(ws + B_ON), WPTR(WS_WA + 8 * MiB), M, D, D, D}; pg8::StaticOrder S; S.init(M, D, G, bx);
        pg8::EpiOut E{(bf16*)(ws + B_H2), D, 0, 0, 1.f, nullptr, 0, 0};
        pg8::gemm_phase<pg8::EpiOut, pg8::StaticOrder, true, true>(lds + RING_OFF, g, S, E);
    }
    SEAM(13);
    if (IN(14)) { PH_IDS resid_rows((const bf16*)(ws + B_H2), out, inptr(lds, 8), out, (bf16*)(ws + B_XN), gw, NGW, lane); }
    SEAM(14);
    FFN_PHASES(1, 15)
#undef IN
#undef SEAM
}

extern "C" void kernel_launch(void* const* d_in, const int* in_sizes, int n_in, void* d_out, int out_size, void* d_ws, size_t ws_size, hipStream_t stream) {
    static int grid = 0;
    if (grid == 0) {
        if (n_in != 19 || in_sizes[0] != M * D || out_size != M * D || ws_size < WS_END) { fprintf(stderr, "kernel_launch: unexpected shapes (n_in %d, in0 %d, out %d, ws %zu); nothing launched\n", n_in, n_in > 0 ? in_sizes[0] : -1, out_size, ws_size); grid = -1; return; }
        int dev = 0, cus = 0, per_cu = 0;
        if (hipGetDevice(&dev) != hipSuccess || hipDeviceGetAttribute(&cus, hipDeviceAttributeMultiprocessorCount, dev) != hipSuccess) { grid = -1; return; }
        if (hipFuncSetAttribute((const void*)yoco_fwd, hipFuncAttributeMaxDynamicSharedMemorySize, LDS_BYTES) != hipSuccess) { fprintf(stderr, "kernel_launch: hipFuncSetAttribute failed\n"); grid = -1; return; }
        if (hipOccupancyMaxActiveBlocksPerMultiprocessor(&per_cu, (const void*)yoco_fwd, NWAVES * 64, LDS_BYTES) != hipSuccess || per_cu < 1) { fprintf(stderr, "kernel_launch: occupancy query says %d\n", per_cu); per_cu = 1; }
        (void)hipGetLastError();
        grid = cus;
    }
    if (grid < 0) return;
    if (hipMemsetAsync((char*)d_ws + WS_CTL, 0, 65536, stream) != hipSuccess) { fprintf(stderr, "kernel_launch: hipMemsetAsync failed\n"); return; }
    Args a{};
    for (int i = 0; i < 19; ++i) a.in[i] = (const float*)d_in[i];
    a.out = (float*)d_out; a.ws = (unsigned char*)d_ws;
    a.lambda_init = (float)(0.8 - 0.6 * exp(-0.3 * 1.0));
    if (N_LAUNCHES == 1) {
        a.ph_lo = 0; a.ph_hi = NPHASE;
        void* kargs[] = {&a};
        hipError_t e = hipLaunchCooperativeKernel((const void*)yoco_fwd, dim3(grid), dim3(NWAVES * 64), kargs, LDS_BYTES, stream);
        if (e != hipSuccess) fprintf(stderr, "kernel_launch: cooperative launch failed: %s (grid %d)\n", hipGetErrorString(e), grid);
    } else {
        for (int p = 0; p < NPHASE; ++p) {
            a.ph_lo = p; a.ph_hi = p + 1;
            hipLaunchKernelGGL(yoco_fwd, dim3(grid), dim3(NWAVES * 64), LDS_BYTES, stream, a);
            const hipError_t le = hipPeekAtLastError();
            if (le != hipSuccess) { fprintf(stderr, "kernel_launch: launch %d failed: %s\n", p, hipGetErrorName(le)); break; }
        }
    }
}
```

```cpp
#include <hip/hip_runtime.h>
#include <hip/hip_bf16.h>
#include <hip/hip_cooperative_groups.h>
#include <cstdio>
#include <cstdint>
#include <cmath>
namespace cg = cooperative_groups;

#ifndef MK_N_LAUNCHES
#define MK_N_LAUNCHES 1
#endif

namespace pg8 {
#define PG8_LAS __attribute__((address_space(3)))
typedef unsigned short bf16_t;
typedef short bf16x8 __attribute__((ext_vector_type(8)));
typedef float f32x4 __attribute__((ext_vector_type(4)));
typedef unsigned u32x4 __attribute__((ext_vector_type(4)));
constexpr int BM = 256, BK = 64, HALF = 128, HTB = HALF * BK * 2  , STAGE_BYTES = 8 * HTB, NXCD = 8, WGM = 8;

__host__ __device__ __forceinline__ int lds_byte(int r, int c) { const int st = (r >> 4) * 2 + (c >> 5), rr = r & 15, cc = c & 31, ob = rr * 64 + cc * 2; return st * 1024 + (ob ^ (((ob >> 9) & 1) << 5)); }
__host__ __device__ __forceinline__ void stage_rc(int b, int& R, int& C) { const int st = b / 1024, sb = b % 1024, swz = sb ^ (((sb >> 9) & 1) << 5); R = (st >> 1) * 16 + swz / 64; C = (st & 1) * 32 + (swz % 64) / 2; }
__host__ __device__ __forceinline__ int perm32(int rho) { const int n = rho >> 4, i = rho & 15; return 8 * (i >> 2) + 4 * n + (i & 3); }

struct Unit { int pm, pn; };
struct Gemm { const bf16_t* A; const bf16_t* Bt; int M, N, K, lda; };

struct StaticOrder {
    int nM, nN, nwg, G, c;
    __host__ __device__ void init(int M, int N, int G_, int c_) { nM = M / BM; nN = N / BM; nwg = nM * nN; G = G_; c = c_; }
    __host__ __device__ bool next(int i, Unit& u) const {
        const long L = (long)i * G + c; if (L >= nwg) return false;
        int wgid = (int)L; { const int q = nwg / NXCD, r = nwg % NXCD, xcd = wgid % NXCD, off = wgid / NXCD; wgid = (xcd < r ? xcd * (q + 1) : r * (q + 1) + (xcd - r) * q) + off; }
        const int nig = WGM * nN, gid = wgid / nig, fm = gid * WGM, gsz = (nM - fm) < WGM ? (nM - fm) : WGM;
        u.pm = fm + ((wgid % nig) % gsz); u.pn = (wgid % nig) / gsz; return true;
    }
    __device__ __forceinline__ void a_ready(const Unit&) const {}
    __device__ __forceinline__ void done(const Unit&) const {}
};

__device__ __forceinline__ unsigned cvt_pk_bf16(float lo, float hi) { unsigned r; asm volatile("v_cvt_pk_bf16_f32 %0, %1, %2" : "=v"(r) : "v"(lo), "v"(hi)); return r; }

struct EpiOut {
    static constexpr bool PERM = true, AFTER_DRAIN = false;
    bf16_t* O; int ldc; int split_cols; size_t split_stride; float scale0; bf16_t* side; int side_pn; int side_ld;
    __device__ __forceinline__ void operator()(const f32x4 (&acc)[2][2][4][2], const Unit& u, int wr, int wc, int fr, int fq) const {
        const int row0 = u.pm * BM + wr * 64 + fr; int colt = u.pn * BM; bf16_t* base = O;
        float sc = 1.f; if (split_cols) { const int t = colt / split_cols; base += (size_t)t * split_stride; colt -= t * split_cols; if (t == 0) sc = scale0; }
        const int col0 = colt + wc * 32 + 8 * fq;
        const bool do_side = (side != nullptr) && (u.pn < side_pn);
#pragma unroll
        for (int ai = 0; ai < 2; ++ai)
#pragma unroll
            for (int m = 0; m < 4; ++m) { const int row = row0 + ai * HALF + m * 16; bf16_t* rowp = base + (size_t)row * ldc + col0;
#pragma unroll
                for (int bj = 0; bj < 2; ++bj) { f32x4 v0 = acc[ai][bj][m][0] * sc, v1 = acc[ai][bj][m][1] * sc;
                    u32x4 w; w.x = cvt_pk_bf16(v0[0], v0[1]); w.y = cvt_pk_bf16(v0[2], v0[3]); w.z = cvt_pk_bf16(v1[0], v1[1]); w.w = cvt_pk_bf16(v1[2], v1[3]);
                    *(u32x4*)(rowp + bj * HALF) = w;
                    if (m == 3) { if (do_side && fr >= 14) *(u32x4*)(side + (size_t)((row >> 6) * 2 + (fr - 14)) * side_ld + col0 + bj * HALF) = w; } } }
    }
};

struct EpiProj {
    static constexpr bool PERM = true, AFTER_DRAIN = false;
    bf16_t* O; int ldc; const float* cosT; const float* sinT;
    __device__ __forceinline__ void operator()(const f32x4 (&acc)[2][2][4][2], const Unit& u, int wr, int wc, int fr, int fq) const {
        const int row0 = u.pm * BM + wr * 64 + fr; const int colt = u.pn * BM; const int j0 = wc * 32 + 8 * fq; const int col0 = colt + j0;
        const int kind = u.pn < 8 ? 0 : (u.pn < 16 ? 1 : 2);
        const float ksc = (u.pn >= 4) ? 0.0625f : 1.0f;
#pragma unroll
        for (int ai = 0; ai < 2; ++ai)
#pragma unroll
            for (int m = 0; m < 4; ++m) { const int row = row0 + ai * HALF + m * 16; bf16_t* rowp = O + (size_t)row * ldc + col0;
                f32x4 o[2][2];
                if (kind == 0) { const int pos = row & 2047;
#pragma unroll
                    for (int n = 0; n < 2; ++n) { const f32x4 c4 = *(const f32x4*)(cosT + pos * 128 + j0 + 4 * n), s4 = *(const f32x4*)(sinT + pos * 128 + j0 + 4 * n);
                        const f32x4 x1 = acc[ai][0][m][n], x2 = acc[ai][1][m][n];
                        o[0][n] = (x1 * c4 - x2 * s4) * ksc; o[1][n] = (x1 * s4 + x2 * c4) * ksc; }
                } else if (kind == 1) {
#pragma unroll
                    for (int bj = 0; bj < 2; ++bj)
#pragma unroll
                        for (int n = 0; n < 2; ++n) o[bj][n] = acc[ai][bj][m][n];
                } else {
#pragma unroll
                    for (int bj = 0; bj < 2; ++bj)
#pragma unroll
                        for (int n = 0; n < 2; ++n) { const f32x4 v = acc[ai][bj][m][n]; f32x4 r;
#pragma unroll
                            for (int e = 0; e < 4; ++e) r[e] = v[e] * __builtin_amdgcn_rcpf(1.0f + __expf(-v[e]));
                            o[bj][n] = r; }
                }
#pragma unroll
                for (int bj = 0; bj < 2; ++bj) { u32x4 w; w.x = cvt_pk_bf16(o[bj][0][0], o[bj][0][1]); w.y = cvt_pk_bf16(o[bj][0][2], o[bj][0][3]); w.z = cvt_pk_bf16(o[bj][1][0], o[bj][1][1]); w.w = cvt_pk_bf16(o[bj][1][2], o[bj][1][3]);
                    *(u32x4*)(rowp + bj * HALF) = w; } }
    }
};

template <class Epi, class Sched, bool ALIGN_EPI = false, bool SP2 = false>
__device__ __forceinline__ void gemm_phase(PG8_LAS unsigned char* lds, const Gemm g, const Sched& S, const Epi& E) {
    const int tid = threadIdx.x, wid = __builtin_amdgcn_readfirstlane(tid >> 6), lane = tid & 63, wr = wid >> 2, wc = wid & 3, fr = lane & 15, fq = lane >> 4;
    const int K = g.K, nt = K / BK;
    unsigned voffA[2], voffB[2];
#pragma unroll
    for (int i = 0; i < 2; ++i) { int R, C; stage_rc(tid * 16 + i * 8192, R, C); const int Rb = Epi::PERM ? ((R & ~31) + perm32(R & 31)) : R;
        voffA[i] = (unsigned)(R * g.lda + C) * 2u; voffB[i] = (unsigned)(Rb * K + C) * 2u; }
    const size_t kstep = (size_t)(BK * 2);
    const size_t hsB = (size_t)HALF * K * 2, hsA = (size_t)HALF * g.lda * 2;
    const size_t tsA = 2 * hsA, tsB = 2 * hsB;
    const unsigned ldsw = (unsigned)wid * 1024u;
    const int aoff = lds_byte(wr * 64 + fr, fq * 8), boff = lds_byte(wc * 32 + fr, fq * 8);
#define PG8_SA(b, h) (((b) * 2 + (h)) * HTB)
#define PG8_SB(b, h) ((4 + (b) * 2 + (h)) * HTB)
#define PG8_STAGE(bufoff, gbase, voff) do { _Pragma("unroll") for (int _i = 0; _i < 2; ++_i) \
        __builtin_amdgcn_global_load_lds((const unsigned*)((const char*)(gbase) + (voff)[_i]), (PG8_LAS unsigned*)(lds + (bufoff) + ldsw + _i * 8192), 16, 0, 0); } while (0)
#define PG8_LDA(dst, b, h) do { _Pragma("unroll") for (int m = 0; m < 4; ++m) _Pragma("unroll") for (int k = 0; k < 2; ++k) dst[m][k] = *(const PG8_LAS bf16x8*)(lds + PG8_SA(b, h) + aoff + m * 2048 + k * 1024); } while (0)
#define PG8_LDB(dst, b, h) do { _Pragma("unroll") for (int n = 0; n < 2; ++n) _Pragma("unroll") for (int k = 0; k < 2; ++k) dst[n][k] = *(const PG8_LAS bf16x8*)(lds + PG8_SB(b, h) + boff + n * 2048 + k * 1024); } while (0)
#define PG8_MMA(ai, bj, At, Bt) do { __builtin_amdgcn_s_setprio(1); _Pragma("unroll") for (int m = 0; m < 4; ++m) _Pragma("unroll") for (int n = 0; n < 2; ++n) _Pragma("unroll") for (int k = 0; k < 2; ++k) \
        acc[ai][bj][m][n] = __builtin_amdgcn_mfma_f32_16x16x32_bf16(Bt[n][k], At[m][k], acc[ai][bj][m][n], 0, 0, 0); __builtin_amdgcn_s_setprio(0); } while (0)
#define PG8_WAIT_V(n) asm volatile("s_waitcnt vmcnt(" #n ")" ::: "memory")
#define PG8_WAIT_L(n) asm volatile("s_waitcnt lgkmcnt(" #n ")" ::: "memory")
#define PG8_BAR __builtin_amdgcn_s_barrier()
#define PG8_SCHED __builtin_amdgcn_sched_barrier(0)
    Unit cur, nxt; int ui = 0;
    if (!S.next(0, cur)) return;
    f32x4 acc[2][2][4][2];
#pragma unroll
    for (int a = 0; a < 2; ++a)
#pragma unroll
        for (int b = 0; b < 2; ++b)
#pragma unroll
            for (int m = 0; m < 4; ++m)
#pragma unroll
                for (int n = 0; n < 2; ++n) acc[a][b][m][n] = (f32x4){0.f, 0.f, 0.f, 0.f};
    bf16x8 At[4][2], B0[2][2], B1[2][2];
    const char* cA = (const char*)g.A + (size_t)cur.pm * tsA; const char* cB = (const char*)g.Bt + (size_t)cur.pn * tsB;
    S.a_ready(cur);
    if constexpr (SP2) {
        PG8_STAGE(PG8_SB(0, 0), cB, voffB); PG8_STAGE(PG8_SB(0, 1), cB + hsB, voffB); PG8_STAGE(PG8_SA(0, 0), cA, voffA); PG8_STAGE(PG8_SA(0, 1), cA + hsA, voffA);
        if (wr == 1) PG8_BAR;
        PG8_WAIT_V(2); PG8_BAR;
        PG8_STAGE(PG8_SB(1, 0), cB + kstep, voffB); PG8_STAGE(PG8_SA(1, 0), cA + kstep, voffA); PG8_STAGE(PG8_SB(1, 1), cB + hsB + kstep, voffB);
        PG8_WAIT_V(6); PG8_BAR;
    } else {
        PG8_STAGE(PG8_SB(0, 0), cB, voffB); PG8_STAGE(PG8_SA(0, 0), cA, voffA); PG8_STAGE(PG8_SB(0, 1), cB + hsB, voffB); PG8_STAGE(PG8_SA(0, 1), cA + hsA, voffA);
        if (wr == 1) PG8_BAR;
        PG8_WAIT_V(4); PG8_BAR;
        PG8_STAGE(PG8_SB(1, 0), cB + kstep, voffB); PG8_STAGE(PG8_SA(1, 0), cA + kstep, voffA); PG8_STAGE(PG8_SB(1, 1), cB + hsB + kstep, voffB);
        PG8_WAIT_V(6); PG8_BAR;
    }
    for (;;) {
        const bool has_next = S.next(ui + 1, nxt);
        const char* nA = has_next ? (const char*)g.A + (size_t)nxt.pm * tsA : cA; const char* nB = has_next ? (const char*)g.Bt + (size_t)nxt.pn * tsB : cB;
        for (int t = 0; t < nt; t += 2) {
            const bool last = (t == nt - 2);
            const char* a1 = cA + (size_t)(t + 1) * kstep;
            const char* a2 = last ? nA : cA + (size_t)(t + 2) * kstep; const char* b2 = last ? nB : cB + (size_t)(t + 2) * kstep;
            const char* a3 = a2 + kstep; const char* b3 = b2 + kstep;
            if (last && has_next) S.a_ready(nxt);
            if constexpr (SP2) {
            PG8_LDB(B0, 0, 0); PG8_LDB(B1, 0, 1); PG8_SCHED; PG8_LDA(At, 0, 0); PG8_STAGE(PG8_SA(1, 1), a1 + hsA, voffA);
            PG8_WAIT_V(8); PG8_WAIT_L(0); PG8_BAR; PG8_MMA(0, 0, At, B0); PG8_MMA(0, 1, At, B1); PG8_BAR; PG8_SCHED;
            PG8_LDA(At, 0, 1); PG8_STAGE(PG8_SB(0, 0), b2, voffB); PG8_STAGE(PG8_SB(0, 1), b2 + hsB, voffB); PG8_STAGE(PG8_SA(0, 0), a2, voffA);
            PG8_WAIT_V(8); PG8_WAIT_L(0); PG8_BAR; PG8_MMA(1, 0, At, B0); PG8_MMA(1, 1, At, B1); PG8_BAR; PG8_SCHED;
            PG8_LDB(B0, 1, 0); PG8_LDB(B1, 1, 1); PG8_SCHED; PG8_LDA(At, 1, 0); PG8_STAGE(PG8_SA(0, 1), a2 + hsA, voffA);
            PG8_WAIT_V(8); PG8_WAIT_L(0); PG8_BAR; PG8_MMA(0, 0, At, B0); PG8_MMA(0, 1, At, B1); PG8_BAR; PG8_SCHED;
            PG8_LDA(At, 1, 1); PG8_STAGE(PG8_SB(1, 0), b3, voffB); PG8_STAGE(PG8_SB(1, 1), b3 + hsB, voffB); PG8_STAGE(PG8_SA(1, 0), a3, voffA);
            PG8_WAIT_V(8); PG8_WAIT_L(0); PG8_BAR; PG8_MMA(1, 0, At, B0); PG8_MMA(1, 1, At, B1); PG8_BAR; PG8_SCHED;
            } else {
            PG8_LDB(B0, 0, 0); PG8_SCHED; PG8_LDA(At, 0, 0); PG8_STAGE(PG8_SA(1, 1), a1 + hsA, voffA);
            PG8_WAIT_L(8); PG8_BAR; PG8_WAIT_L(0); PG8_MMA(0, 0, At, B0); PG8_BAR; PG8_SCHED;
            PG8_LDB(B1, 0, 1); PG8_STAGE(PG8_SB(0, 0), b2, voffB);
            PG8_BAR; PG8_WAIT_L(0); PG8_MMA(0, 1, At, B1); PG8_BAR;
            PG8_LDA(At, 0, 1); PG8_STAGE(PG8_SA(0, 0), a2, voffA);
            PG8_BAR; PG8_WAIT_L(0); PG8_MMA(1, 0, At, B0); PG8_BAR; PG8_SCHED;
            PG8_STAGE(PG8_SB(0, 1), b2 + hsB, voffB);
            PG8_WAIT_V(6); PG8_BAR; PG8_MMA(1, 1, At, B1); PG8_BAR;
            PG8_LDB(B0, 1, 0); PG8_SCHED; PG8_LDA(At, 1, 0); PG8_STAGE(PG8_SA(0, 1), a2 + hsA, voffA);
            PG8_WAIT_L(8); PG8_BAR; PG8_WAIT_L(0); PG8_MMA(0, 0, At, B0); PG8_BAR; PG8_SCHED;
            PG8_LDB(B1, 1, 1); PG8_STAGE(PG8_SB(1, 0), b3, voffB);
            PG8_BAR; PG8_WAIT_L(0); PG8_MMA(0, 1, At, B1); PG8_BAR;
            PG8_LDA(At, 1, 1); PG8_STAGE(PG8_SA(1, 0), a3, voffA);
            PG8_BAR; PG8_WAIT_L(0); PG8_MMA(1, 0, At, B0); PG8_BAR; PG8_SCHED;
            PG8_STAGE(PG8_SB(1, 1), b3 + hsB, voffB);
            PG8_WAIT_V(6); PG8_BAR; PG8_MMA(1, 1, At, B1); PG8_BAR;
            }
        }
        if constexpr (ALIGN_EPI) { if (wr == 0) PG8_BAR; }
        if constexpr (!Epi::AFTER_DRAIN) { E(acc, cur, wr, wc, fr, fq); S.done(cur); }
        if (!has_next) break;
#pragma unroll
        for (int a = 0; a < 2; ++a)
#pragma unroll
            for (int b = 0; b < 2; ++b)
#pragma unroll
                for (int m = 0; m < 4; ++m)
#pragma unroll
                    for (int n = 0; n < 2; ++n) acc[a][b][m][n] = (f32x4){0.f, 0.f, 0.f, 0.f};
        cur = nxt; cA = nA; cB = nB; ++ui;
        if constexpr (ALIGN_EPI) { if (wr == 1) PG8_BAR; }
    }
    PG8_WAIT_V(0);
    if constexpr (!ALIGN_EPI) { if (wr == 0) PG8_BAR; }
    PG8_BAR;
    if constexpr (Epi::AFTER_DRAIN) { E.fused(acc, cur, wr, wc, fr, fq, lds, wid, lane); S.done(cur); }
#undef PG8_SA
#undef PG8_SB
#undef PG8_STAGE
#undef PG8_LDA
#undef PG8_LDB
#undef PG8_MMA
#undef PG8_WAIT_V
#undef PG8_WAIT_L
#undef PG8_BAR
#undef PG8_SCHED
}
}
namespace attn_body {
using bf16=__hip_bfloat16;
using bf16x8=__attribute__((ext_vector_type(8)))short;
using s16x4=__attribute__((ext_vector_type(4)))short;
using f32x16=__attribute__((ext_vector_type(16)))float;
using u32x4=__attribute__((ext_vector_type(4)))unsigned;
constexpr int BATCH=8,NHEAD=16,SEQ=2048,D=64,DM=1024;
constexpr int NW=8,QBLK=32,QB=QBLK*NW,KVBLK=64,NQB=SEQ/QB;
constexpr int ATTN_PITCH=DM, ATTN_UNIT_ROWS=QB;
__device__ __forceinline__ int crow(int r,int hi){return (r&3)+8*(r>>2)+4*hi;}
#define SBAR() __builtin_amdgcn_sched_barrier(0)
__device__ __forceinline__ void cmask(f32x16&p0,f32x16&p1,int jb,int qrel,int hi){
  const float NEG=-INFINITY; int kb=64*jb+4*hi;
  #pragma unroll
  for(int r=0;r<16;++r){int kv=kb+(r&3)+8*(r>>2); if(kv>qrel)p0[r]=NEG; if(kv+32>qrel)p1[r]=NEG;}
}

constexpr int NSLOT=3, SLOTB=8192;
constexpr int LDS_K=0, LDS_V=NSLOT*SLOTB, LDS_WS=2*NSLOT*SLOTB, LDS_OST=LDS_WS+NW*64*4, LDS_BYTES=LDS_OST+NW*4096;
constexpr float C2=0.125f*1.4426950408889634f;
__device__ __forceinline__ void glds16(const void*gsrc,unsigned lds_dst){unsigned keep;
  asm volatile("s_mov_b32 %0, m0\n\ts_mov_b32 m0, %2\n\ts_nop 0\n\tglobal_load_lds_dwordx4 %1, off\n\ts_mov_b32 m0, %0":"=&s"(keep):"v"(gsrc),"s"(lds_dst):"memory");}
__device__ __forceinline__ float max3f(float a,float b,float c){float r;asm("v_max3_f32 %0, %1, %2, %3":"=v"(r):"v"(a),"v"(b),"v"(c));return r;}
__device__ __forceinline__ float max2f(float a,float b){float r;asm("v_max_f32_e32 %0, %1, %2":"=v"(r):"v"(a),"v"(b));return r;}
__device__ __forceinline__ float fadd_s(float a,float b){float r;asm("v_add_f32_e32 %0, %1, %2":"=v"(r):"v"(a),"v"(b));return r;}
__device__ __forceinline__ float fsub_s(float a,float b){float r;asm("v_sub_f32_e32 %0, %1, %2":"=v"(r):"v"(a),"v"(b));return r;}
typedef float f32x2_t __attribute__((ext_vector_type(2))); typedef __bf16 bf16x2_t __attribute__((ext_vector_type(2)));
__device__ __forceinline__ unsigned cvtpk_s(float lo,float hi){f32x2_t v={lo,hi};bf16x2_t b=__builtin_convertvector(v,bf16x2_t);return __builtin_bit_cast(unsigned,b);}
#define WAIT_BAR(N) asm volatile("s_waitcnt vmcnt(" #N ") lgkmcnt(0)\n\ts_barrier":::"memory")

__device__ __forceinline__ void qkt(f32x16&p0,f32x16&p1,const char*Kslot,const bf16x8*qr,const f32x16&negm,int r32,int hi){
  const char*kb=Kslot+hi*1024+r32*16;
  #pragma unroll
  for(int d0=0;d0<4;++d0){
    const bf16x8 b0=*reinterpret_cast<const bf16x8*>(kb+d0*2048);
    const bf16x8 b1=*reinterpret_cast<const bf16x8*>(kb+d0*2048+512);
    if(d0==0){p0=__builtin_amdgcn_mfma_f32_32x32x16_bf16(b0,qr[0],negm,0,0,0);p1=__builtin_amdgcn_mfma_f32_32x32x16_bf16(b1,qr[0],negm,0,0,0);}
    else{p0=__builtin_amdgcn_mfma_f32_32x32x16_bf16(b0,qr[d0],p0,0,0,0);p1=__builtin_amdgcn_mfma_f32_32x32x16_bf16(b1,qr[d0],p1,0,0,0);}}
}
typedef __attribute__((address_space(3))) const char* lds_cptr;
typedef short v4i16_t __attribute__((ext_vector_type(4)));
__device__ __forceinline__ void kload8(bf16x8*kf,lds_cptr kp){
  kf[0]=*(const __attribute__((address_space(3))) bf16x8*)(kp);      kf[1]=*(const __attribute__((address_space(3))) bf16x8*)(kp+512);
  kf[2]=*(const __attribute__((address_space(3))) bf16x8*)(kp+2048); kf[3]=*(const __attribute__((address_space(3))) bf16x8*)(kp+2560);
  kf[4]=*(const __attribute__((address_space(3))) bf16x8*)(kp+4096); kf[5]=*(const __attribute__((address_space(3))) bf16x8*)(kp+4608);
  kf[6]=*(const __attribute__((address_space(3))) bf16x8*)(kp+6144); kf[7]=*(const __attribute__((address_space(3))) bf16x8*)(kp+6656);
}
__device__ __forceinline__ void kload2(bf16x8*kf,lds_cptr kp,int j){ kf[2*j]=*(const __attribute__((address_space(3))) bf16x8*)(kp+j*2048); kf[2*j+1]=*(const __attribute__((address_space(3))) bf16x8*)(kp+j*2048+512); }
__device__ __forceinline__ s16x4 vtr(lds_cptr p){ return __builtin_bit_cast(s16x4,__builtin_amdgcn_ds_read_tr16_b64_v4i16((__attribute__((address_space(3))) v4i16_t*)p)); }
__device__ __forceinline__ float rowmax(const f32x16&p0,const f32x16&p1){
  float a=max3f(p0[0],p0[1],p1[0]),b=max3f(p0[2],p0[3],p1[1]);a=max3f(a,p1[2],p1[3]);
  #pragma unroll
  for(int r=4;r<16;r+=4){a=max3f(a,p0[r],p0[r+1]);b=max3f(b,p0[r+2],p0[r+3]);a=max3f(a,p1[r],p1[r+1]);b=max3f(b,p1[r+2],p1[r+3]);}
  const float m=max2f(a,b);
  auto rr=__builtin_amdgcn_permlane32_swap(__float_as_uint(m),__float_as_uint(m),false,false);
  return max2f(__uint_as_float(rr[0]),__uint_as_float(rr[1]));
}
__device__ __forceinline__ void pv(f32x16*o,int vb,bf16x8 pa0,bf16x8 pa1,bf16x8 pa2,bf16x8 pa3){
  #pragma unroll
  for(int d0=0;d0<2;++d0){s16x4 lo[4],hi[4];
    #pragma unroll
    for(int ks=0;ks<4;++ks){
      asm volatile("ds_read_b64_tr_b16 %0,%1 offset:%c2":"=&v"(lo[ks]):"v"(vb),"i"(d0*4096+ks*1024):"memory");
      asm volatile("ds_read_b64_tr_b16 %0,%1 offset:%c2":"=&v"(hi[ks]):"v"(vb),"i"(d0*4096+ks*1024+512):"memory");}
    asm volatile("s_waitcnt lgkmcnt(0)":::"memory");SBAR();
    #define PK(k) (bf16x8){lo[k][0],lo[k][1],lo[k][2],lo[k][3],hi[k][0],hi[k][1],hi[k][2],hi[k][3]}
    o[d0]=__builtin_amdgcn_mfma_f32_32x32x16_bf16(pa0,PK(0),o[d0],0,0,0);
    o[d0]=__builtin_amdgcn_mfma_f32_32x32x16_bf16(pa1,PK(1),o[d0],0,0,0);
    o[d0]=__builtin_amdgcn_mfma_f32_32x32x16_bf16(pa2,PK(2),o[d0],0,0,0);
    o[d0]=__builtin_amdgcn_mfma_f32_32x32x16_bf16(pa3,PK(3),o[d0],0,0,0);
    #undef PK
  }
}

#ifndef ATTN_STORE16
#define ATTN_STORE16(p,v) (*(u32x4*)(p)=(v))
#endif
template<int THRL> __device__ __forceinline__ void attn_unit(int b,int qkcol,int vcol,int qb,const bf16*Q,const bf16*__restrict__ K,const bf16*__restrict__ V,bf16*O,char*shm){
  const int tid=threadIdx.x,lane=tid&63,r32=lane&31,hi=lane>>5; const int wid=__builtin_amdgcn_readfirstlane(tid>>6);
  const long rowbase=(long)b*SEQ; const int q0=qb*QB;
  const bf16*Qw=Q+(rowbase+q0+wid*QBLK)*DM+qkcol;
  const bf16*Kh=K+rowbase*DM+qkcol,*Vh=V+rowbase*DM+vcol;
  const unsigned lds0=(unsigned)(uintptr_t)shm;
  float*wsf=(float*)(shm+LDS_WS)+wid*64;
  const bf16*ksrc=Kh+(long)lane*DM+wid*8;
  const bf16*vsrc=Vh+(long)(16*(wid&3)+(lane>>2))*DM+(wid>>2)*32+(lane&3)*8;
  const unsigned kdst=lds0+LDS_K+wid*1024, vdst=lds0+LDS_V+wid*1024;
  #define DMA_K(t,slot) glds16(ksrc+(long)(t)*KVBLK*DM,(unsigned)__builtin_amdgcn_readfirstlane(kdst+(slot)))
  #define DMA_V(t,slot) glds16(vsrc+(long)(t)*KVBLK*DM,(unsigned)__builtin_amdgcn_readfirstlane(vdst+(slot)))
  const int vb0=(int)(lds0+LDS_V)+((lane>>4)&1)*32+(lane&3)*8+(4*hi+((lane&15)>>2))*64;
  const char*Kbase=shm+LDS_K; bf16x8 kf[8];
  const lds_cptr shm3=(lds_cptr)shm; const lds_cptr kp0=shm3+LDS_K+hi*1024+r32*16; const lds_cptr vp0=shm3+LDS_V+((lane>>4)&1)*32+(lane&3)*8+(4*hi+((lane&15)>>2))*64;
  const int NT=(q0+QB)/KVBLK;
  DMA_K(0,0);DMA_V(0,0);DMA_K(1,SLOTB);
  bf16x8 qr[4];
  #pragma unroll
  for(int d0=0;d0<4;++d0)qr[d0]=*reinterpret_cast<const bf16x8*>(&Qw[(long)r32*DM+d0*16+hi*8]);
  float mhat=0.f,l_reg=0.f;f32x16 o[2];o[0]=f32x16{};o[1]=f32x16{};f32x16 negm=f32x16{};asm volatile("":"+v"(negm));
  const int qrel=wid*QBLK+r32;
  #define CMASK(P0,P1,t) do{int jb_=(t)-(NT-4); if(jb_>=0)cmask(P0,P1,jb_,qrel,hi);}while(0)
  bool resc=false;
  #define START(P0,P1) do{ const float rm=rowmax(P0,P1); resc=false; \
    { const float dl=rm; mhat=fadd_s(mhat,dl); \
      _Pragma("unroll") for(int r=0;r<16;++r){P0[r]=fsub_s(P0[r],dl);P1[r]=fsub_s(P1[r],dl);} \
      _Pragma("unroll") for(int r=0;r<16;++r)negm[r]=-mhat; asm volatile("":"+v"(negm)); } \
    _Pragma("unroll") for(int r=0;r<16;++r)P0[r]=__builtin_amdgcn_exp2f(P0[r]); }while(0)
  #define RESC() do{ if(resc){ asm volatile("s_waitcnt lgkmcnt(0)":::"memory"); \
      _Pragma("unroll") for(int d_=0;d_<2;++d_) _Pragma("unroll") for(int r=0;r<16;++r)o[d_][r]*=wsf[crow(r,hi)]; } }while(0)
  f32x16 pA0,pA1,pB0,pB1;
  int sl_prev=0,sl_cur=0,sl_next=SLOTB;
  #define ROT() do{sl_prev=sl_cur;sl_cur=sl_next;sl_next=(sl_next==(NSLOT-1)*SLOTB)?0:sl_next+SLOTB;}while(0)
  DMA_K(2,2*SLOTB);
  WAIT_BAR(3);
  qkt(pA0,pA1,Kbase,qr,negm,r32,hi);asm volatile("s_nop 15\n\ts_nop 7":"+v"(pA0),"+v"(pA1));CMASK(pA0,pA1,0);
  START(pA0,pA1);
  _Pragma("unroll") for(int r=0;r<16;++r)pA1[r]=__builtin_amdgcn_exp2f(pA1[r]);
  WAIT_BAR(0);
  DMA_K(3,0);DMA_V(1,SLOTB);
  ROT();
  kload8(kf,kp0+sl_cur);
  WAIT_BAR(2);
  s16x4 vlo[8],vhi[8]; u32x4 pw0,pw1,pw2,pw3;
  #define PKW(P,B) cvtpk_s(P[B],P[B+1])
  #define PAF(k) __builtin_bit_cast(bf16x8,pw##k)
  #define VFR(i) (bf16x8){vlo[i][0],vlo[i][1],vlo[i][2],vlo[i][3],vhi[i][0],vhi[i][1],vhi[i][2],vhi[i][3]}
  #define PIN(x) asm volatile("":"+v"(x))
  #define MX3(a,b,c) __builtin_fmaxf(__builtin_fmaxf((a),(b)),(c))
  #define GAPA(MF,A0,A1,A2,A3,W0,W1,PW) do{ MF; sacc+=A0; sacc+=A1; sacc+=A2; sacc+=A3; PIN(sacc); W0; W1; PIN(PW); SBAR(); }while(0)
  #define EX(v) __builtin_amdgcn_exp2f(v)
  #define GAPB(MF,X,B) do{ MF; X[B]=EX(X[B]); X[B+1]=EX(X[B+1]); X[B+2]=EX(X[B+2]); X[B+3]=EX(X[B+3]); PIN(X); SBAR(); }while(0)
  #define VRD(i) do{ vlo[i]=vtr(vp_+(((i)>>2)*4096+((i)&3)*1024)); vhi[i]=vtr(vp_+(((i)>>2)*4096+((i)&3)*1024+512)); }while(0)
  #define KRD(G,j) do{ if(G){ kload2(kf,kp0+sl_next,j); SBAR(); } }while(0)
  #define STEP(C0,C1,P0,P1,t,GK,GV,GL) do{ SBAR(); \
    const lds_cptr vp_=vp0+sl_prev; \
    VRD(0); SBAR(); float sacc=(P0[0]+P0[1]); \
    GAPA(C0=__builtin_amdgcn_mfma_f32_32x32x16_bf16(kf[0],qr[0],negm,0,0,0), P0[2],P0[3],P0[4],P0[5],     pw0[0]=PKW(P0,0), pw0[1]=PKW(P0,2), pw0); \
    VRD(4); SBAR(); GAPA(C1=__builtin_amdgcn_mfma_f32_32x32x16_bf16(kf[1],qr[0],negm,0,0,0), P0[6],P0[7],P0[8],P0[9],     pw0[2]=PKW(P0,4), pw0[3]=PKW(P0,6), pw0); \
    VRD(1); SBAR(); GAPA(C0=__builtin_amdgcn_mfma_f32_32x32x16_bf16(kf[2],qr[1],C0,0,0,0),   P0[10],P0[11],P0[12],P0[13], pw1[0]=PKW(P0,8), pw1[1]=PKW(P0,10), pw1); \
    VRD(5); SBAR(); GAPA(C1=__builtin_amdgcn_mfma_f32_32x32x16_bf16(kf[3],qr[1],C1,0,0,0),   P0[14],P0[15],P1[0],P1[1],   pw1[2]=PKW(P0,12),pw1[3]=PKW(P0,14), pw1); \
    VRD(2); SBAR(); GAPA(C0=__builtin_amdgcn_mfma_f32_32x32x16_bf16(kf[4],qr[2],C0,0,0,0),   P1[2],P1[3],P1[4],P1[5],     pw2[0]=PKW(P1,0), pw2[1]=PKW(P1,2), pw2); \
    VRD(6); SBAR(); GAPA(C1=__builtin_amdgcn_mfma_f32_32x32x16_bf16(kf[5],qr[2],C1,0,0,0),   P1[6],P1[7],P1[8],P1[9],     pw2[2]=PKW(P1,4), pw2[3]=PKW(P1,6), pw2); \
    VRD(3); SBAR(); GAPA(C0=__builtin_amdgcn_mfma_f32_32x32x16_bf16(kf[6],qr[3],C0,0,0,0),   P1[10],P1[11],P1[12],P1[13], pw3[0]=PKW(P1,8), pw3[1]=PKW(P1,10), pw3); \
    VRD(7); SBAR(); GAPA(C1=__builtin_amdgcn_mfma_f32_32x32x16_bf16(kf[7],qr[3],C1,0,0,0),   P1[14],P1[15],0.f,0.f,       pw3[2]=PKW(P1,12),pw3[3]=PKW(P1,14), pw3); \
    l_reg+=sacc; \
    if(GK){DMA_K((t)+3,sl_cur);} if(GV){DMA_V((t)+1,sl_next);} \
    CMASK(C0,C1,t); \
    { float a=MX3(C0[0],C0[1],C1[0]),b=MX3(C0[2],C0[3],C1[1]); a=MX3(a,C1[2],C1[3]); \
      _Pragma("unroll") for(int r=4;r<16;r+=4){a=MX3(a,C0[r],C0[r+1]);b=MX3(b,C0[r+2],C0[r+3]);a=MX3(a,C1[r],C1[r+1]);b=MX3(b,C1[r+2],C1[r+3]);} \
      float rm=__builtin_fmaxf(a,b); { auto rr=__builtin_amdgcn_permlane32_swap(__float_as_uint(rm),__float_as_uint(rm),false,false); rm=__builtin_fmaxf(__uint_as_float(rr[0]),__uint_as_float(rr[1])); } \
      resc=false; \
      if(__builtin_expect(__any(rm>(float)THRL),0)){ const float dl=__builtin_fmaxf(rm,0.f); mhat+=dl; \
        _Pragma("unroll") for(int r=0;r<16;++r){C0[r]-=dl;C1[r]-=dl;} \
        _Pragma("unroll") for(int r=0;r<16;++r)negm[r]=-mhat; asm volatile("":"+v"(negm)); \
        const float f=__builtin_amdgcn_exp2f(-dl); l_reg*=f; if(hi==0)wsf[r32]=f; resc=true; } } \
    SBAR(); \
    GAPB(o[0]=__builtin_amdgcn_mfma_f32_32x32x16_bf16(PAF(0),VFR(0),o[0],0,0,0), C0,0); \
    GAPB(o[1]=__builtin_amdgcn_mfma_f32_32x32x16_bf16(PAF(0),VFR(4),o[1],0,0,0), C0,4); \
    KRD(GL,0); GAPB(o[0]=__builtin_amdgcn_mfma_f32_32x32x16_bf16(PAF(1),VFR(1),o[0],0,0,0), C0,8); \
    KRD(GL,1); GAPB(o[1]=__builtin_amdgcn_mfma_f32_32x32x16_bf16(PAF(1),VFR(5),o[1],0,0,0), C0,12); \
    KRD(GL,2); GAPB(o[0]=__builtin_amdgcn_mfma_f32_32x32x16_bf16(PAF(2),VFR(2),o[0],0,0,0), C1,0); \
    KRD(GL,3); GAPB(o[1]=__builtin_amdgcn_mfma_f32_32x32x16_bf16(PAF(2),VFR(6),o[1],0,0,0), C1,4); \
    GAPB(o[0]=__builtin_amdgcn_mfma_f32_32x32x16_bf16(PAF(3),VFR(3),o[0],0,0,0), C1,8); \
    GAPB(o[1]=__builtin_amdgcn_mfma_f32_32x32x16_bf16(PAF(3),VFR(7),o[1],0,0,0), C1,12); \
    }while(0)
  int t=1;
  #undef CMASK
  #define CMASK(P0,P1,t) do{}while(0)
  for(;t+5<NT;t+=2){
    STEP(pB0,pB1,pA0,pA1,t,true,true,true);     WAIT_BAR(2); RESC(); ROT();
    STEP(pA0,pA1,pB0,pB1,t+1,true,true,true);   WAIT_BAR(2); RESC(); ROT();
  }
  #undef CMASK
  #define CMASK(P0,P1,t) do{int jb_=(t)-(NT-4); if(jb_>=0)cmask(P0,P1,jb_,qrel,hi);}while(0)
  #define ENDW(tt) do{ if((tt)+3<NT){WAIT_BAR(2);} else if((tt)+2<NT){WAIT_BAR(1);} else {WAIT_BAR(0);} }while(0)
  for(;t+1<NT;t+=2){
    STEP(pB0,pB1,pA0,pA1,t,(t+3<NT),(t+1<NT),(t+1<NT));       ENDW(t);   RESC(); ROT();
    STEP(pA0,pA1,pB0,pB1,t+1,(t+4<NT),(t+2<NT),(t+2<NT));     ENDW(t+1); RESC(); ROT();
  }
  STEP(pB0,pB1,pA0,pA1,NT-1,false,false,false); RESC();
  { float sacc=pB0[0]+pB0[1]; _Pragma("unroll") for(int r=2;r<16;++r)sacc+=pB0[r]; _Pragma("unroll") for(int r=0;r<16;++r)sacc+=pB1[r]; l_reg+=sacc;
    pw0=(u32x4){PKW(pB0,0),PKW(pB0,2),PKW(pB0,4),PKW(pB0,6)};pw1=(u32x4){PKW(pB0,8),PKW(pB0,10),PKW(pB0,12),PKW(pB0,14)};pw2=(u32x4){PKW(pB1,0),PKW(pB1,2),PKW(pB1,4),PKW(pB1,6)};pw3=(u32x4){PKW(pB1,8),PKW(pB1,10),PKW(pB1,12),PKW(pB1,14)};
    SBAR(); pv(o,vb0+sl_cur,PAF(0),PAF(1),PAF(2),PAF(3)); }
  #undef PKW
  #undef PAF
  #undef VFR
  #undef PIN
  #undef MX3
  #undef GAPA
  #undef GAPB
  #undef EX
  #undef VRD
  #undef KRD
  #undef STEP
  #undef ENDW
  {auto rr=__builtin_amdgcn_permlane32_swap(__float_as_uint(l_reg),__float_as_uint(l_reg),false,false);l_reg=__uint_as_float(rr[0])+__uint_as_float(rr[1]);}
  if(hi==0)wsf[32+r32]=l_reg;asm volatile("s_waitcnt lgkmcnt(0)":::"memory");
  float rli[16];
  #pragma unroll
  for(int r=0;r<16;++r)rli[r]=__builtin_amdgcn_rcpf(wsf[32+crow(r,hi)]);
  bf16*Ow=O+(rowbase+q0+wid*QBLK)*DM+vcol;
  { bf16*stg=(bf16*)(shm+LDS_OST)+wid*2048;
    #pragma unroll
    for(int r=0;r<16;++r){const int orow=crow(r,hi);
      #pragma unroll
      for(int d0=0;d0<2;++d0)stg[orow*64+d0*32+r32]=__float2bfloat16(o[d0][r]*rli[r]);}
    asm volatile("s_waitcnt lgkmcnt(0)":::"memory");
    #pragma unroll
    for(int i=0;i<4;++i){const int row=i*8+(lane>>3),ch=lane&7; const u32x4 v=*(const u32x4*)(stg+row*64+ch*8); ATTN_STORE16(Ow+(long)row*DM+ch*8,v);} }
  asm volatile("s_waitcnt lgkmcnt(0)\n\ts_barrier":::"memory");
  #undef DMA_K
  #undef DMA_V
  #undef CMASK
  #undef START
  #undef RESC
  #undef ROT
}
constexpr int ATTN_LDS_BYTES=LDS_BYTES;
struct AttnTensors { const bf16* Q; const bf16* K; const bf16* V; bf16* O0; bf16* O1; };
struct AttnUnit { int bh; int qb; };
struct StaticOrder {
  int vcu;
  __device__ __forceinline__ explicit StaticOrder(int grid,int block):vcu((block%8)*(grid/8)+block/8){}
  __device__ __forceinline__ bool next(int i,AttnUnit&u)const{ if(i>=8)return false; const int s=vcu&7; u.bh=vcu; u.qb=(i+s)&7; return true; }
  __device__ __forceinline__ void a_ready(const AttnUnit&)const{}
  __device__ __forceinline__ void done(const AttnUnit&)const{}
};
template<class Sched,int THRL=8> __device__ __forceinline__ void attn_phase(char*lds,const AttnTensors&T,const Sched&S){
  AttnUnit u;
  for(int i=0;S.next(i,u);++i){ S.a_ready(u); { const int vh=u.bh&31,hh=vh>>2,cc=(vh>>1)&1,hf=vh&1; attn_unit<THRL>(u.bh>>5,(hh*2+cc)*64,hh*128+hf*64,u.qb,T.Q,T.K,T.V,cc?T.O1:T.O0,lds); } S.done(u); }
}
#undef SBAR
#undef WAIT_BAR
}

constexpr int NWAVES = 8;
constexpr int N_LAUNCHES = MK_N_LAUNCHES;
constexpr int NPHASE = 19;
constexpr int M = 16384, SEQ = 2048, D = 1024, NPROJ = 6144, RV = 2048, FF = 2816, FF2 = 5632;
constexpr float EPS = 1e-6f;
constexpr size_t MiB = 1u << 20;
constexpr size_t WS_CTL = 0, CTL_ZERO_BYTES = 1 * MiB;
constexpr size_t WS_COS = 1 * MiB, WS_SIN = 2 * MiB;
constexpr size_t WS_WA = 4 * MiB;
constexpr size_t WS_WB = 16 * MiB;
constexpr size_t WS_WC = 20 * MiB;
constexpr size_t WS_WD = 31 * MiB;
constexpr size_t WS_BIG = 37 * MiB;
constexpr size_t B_PROJ = WS_BIG;
constexpr size_t B_H = WS_BIG;
constexpr size_t B_UP = WS_BIG;
constexpr size_t B_XN = WS_BIG + 176 * MiB;
constexpr size_t B_SIDE = WS_BIG + 208 * MiB;
constexpr size_t B_XN2 = WS_BIG;
constexpr size_t B_QKV = WS_BIG + 32 * MiB;
constexpr size_t B_O0 = WS_BIG + 128 * MiB, B_O1 = WS_BIG + 160 * MiB;
constexpr size_t B_ON = WS_BIG;
constexpr size_t B_H2 = WS_BIG + 32 * MiB;
constexpr size_t WS_END = 256 * MiB;
static_assert(B_SIDE + (size_t)256 * 2 * FF * 2 <= WS_END && B_PROJ + (size_t)M * NPROJ * 2 <= WS_END && B_O1 + (size_t)M * D * 2 <= WS_END, "d_ws map");
constexpr int RING_OFF = 0, RING_BYTES = 131072;
constexpr int LDS_BYTES = 147456;

#define GAS __attribute__((address_space(1)))
#define LAS __attribute__((address_space(3)))
#define DI __device__ __forceinline__
typedef unsigned short bf16;
typedef unsigned v4u __attribute__((ext_vector_type(4)));
typedef unsigned v2u __attribute__((ext_vector_type(2)));
typedef float f32x4 __attribute__((ext_vector_type(4)));
typedef short bf16x8 __attribute__((ext_vector_type(8)));
typedef short v4i16 __attribute__((ext_vector_type(4)));
typedef float f32x2v __attribute__((ext_vector_type(2)));
typedef __bf16 bf16x2v __attribute__((ext_vector_type(2)));
#define LDS_WAIT() asm volatile("s_waitcnt lgkmcnt(0)" ::: "memory")

DI unsigned pk2(float lo, float hi) { f32x2v v = {lo, hi}; bf16x2v b = __builtin_convertvector(v, bf16x2v); return __builtin_bit_cast(unsigned, b); }
DI float bflo(unsigned w) { return __uint_as_float(w << 16); }
DI float bfhi(unsigned w) { return __uint_as_float(w & 0xffff0000u); }
DI float wave_sum(float v) {
#pragma unroll
    for (int o = 1; o < 64; o <<= 1) v += __shfl_xor(v, o);
    return v;
}

DI void transpose_item(const float* W, int K, int N, bf16* WT, int row_off, const float* gain, int kmod, float cs, LAS float* scr, int item, int lane) {
    const int nblk = N / 32, kb = item / nblk, nb = item % nblk, k0 = 64 * kb, n0 = 32 * nb;
#pragma unroll 8
    for (int i = 0; i < 32; ++i) { const int kk = 2 * i + (lane >> 5); float g = cs; if (gain) g *= gain[(k0 + kk) % kmod];
        scr[kk * 33 + (lane & 31)] = W[(size_t)(k0 + kk) * N + n0 + (lane & 31)] * g; }
    LDS_WAIT(); asm volatile("" ::: "memory");
    const int c = lane & 7;
#pragma unroll
    for (int j = 0; j < 4; ++j) { const int n = (lane >> 3) + 8 * j; const LAS float* s = scr + (8 * c) * 33 + n;
        v4u o; o.x = pk2(s[0 * 33], s[1 * 33]); o.y = pk2(s[2 * 33], s[3 * 33]); o.z = pk2(s[4 * 33], s[5 * 33]); o.w = pk2(s[6 * 33], s[7 * 33]);
        *(v4u*)(WT + (size_t)(row_off + n0 + n) * K + k0 + 8 * c) = o; }
    LDS_WAIT(); asm volatile("" ::: "memory");
}
DI void convert_matrix(const float* W, int K, int N, bf16* WT, int row_off, const float* gain, int kmod, float cs, LAS unsigned char* lds, int gw, int NGW, int wave, int lane) {
    LAS float* scr = (LAS float*)(lds + RING_OFF + wave * 16384);
    const int nitems = (K / 64) * (N / 32);
    for (int it = gw; it < nitems; it += NGW) transpose_item(W, K, N, WT, row_off, gain, kmod, cs, scr, it, lane);
}

DI void norm_rows(const float* x, bf16* xn, int gw, int NGW, int lane) {
    for (int m = gw; m < M; m += NGW) {
        const f32x4* xr = (const f32x4*)(x + (size_t)m * D) + lane;
        f32x4 v[4]; float s = 0.f;
#pragma unroll
        for (int j = 0; j < 4; ++j) { v[j] = xr[64 * j]; s += (v[j].x * v[j].x + v[j].y * v[j].y) + (v[j].z * v[j].z + v[j].w * v[j].w); }
        const float rstd = 1.0f / sqrtf(wave_sum(s) * (1.f / D) + EPS);
        v2u* o8 = (v2u*)(xn + (size_t)m * D) + lane;
#pragma unroll
        for (int j = 0; j < 4; ++j) { v2u w; w.x = pk2(v[j].x * rstd, v[j].y * rstd); w.y = pk2(v[j].z * rstd, v[j].w * rstd); o8[64 * j] = w; }
    }
}
DI void resid_rows(const bf16* h, const float* base, const float* gain, float* xo, bf16* xn, int gw, int NGW, int lane) {
    f32x4 gv[4];
#pragma unroll
    for (int j = 0; j < 4; ++j) gv[j] = ((const f32x4*)gain)[lane + 64 * j];
    for (int m = gw; m < M; m += NGW) {
        const v2u* hr = (const v2u*)(h + (size_t)m * D) + lane;
        const f32x4* br = (const f32x4*)(base + (size_t)m * D) + lane;
        f32x4 hv[4], bv[4]; float s = 0.f;
#pragma unroll
        for (int j = 0; j < 4; ++j) { const v2u w = hr[64 * j]; hv[j] = (f32x4){bflo(w.x), bfhi(w.x), bflo(w.y), bfhi(w.y)}; bv[j] = br[64 * j];
            s += (hv[j].x * hv[j].x + hv[j].y * hv[j].y) + (hv[j].z * hv[j].z + hv[j].w * hv[j].w); }
        const float rstd = 1.0f / sqrtf(wave_sum(s) * (1.f / D) + EPS);
        float s2 = 0.f;
#pragma unroll
        for (int j = 0; j < 4; ++j) { hv[j] = bv[j] + hv[j] * rstd * gv[j]; s2 += (hv[j].x * hv[j].x + hv[j].y * hv[j].y) + (hv[j].z * hv[j].z + hv[j].w * hv[j].w); }
        f32x4* orow = (f32x4*)(xo + (size_t)m * D) + lane;
#pragma unroll
        for (int j = 0; j < 4; ++j) orow[64 * j] = hv[j];
        if (xn) {
            const float r2 = 1.0f / sqrtf(wave_sum(s2) * (1.f / D) + EPS);
            v2u* o8 = (v2u*)(xn + (size_t)m * D) + lane;
#pragma unroll
            for (int j = 0; j < 4; ++j) { v2u w; w.x = pk2(hv[j].x * r2, hv[j].y * r2); w.y = pk2(hv[j].z * r2, hv[j].w * r2); o8[64 * j] = w; }
        }
    }
}
DI void y_rows(bf16* outraw, const bf16* proj, int gw, int NGW, int lane) {
    for (int m = gw; m < M; m += NGW) {
#pragma unroll
        for (int hh = 0; hh < 4; ++hh) {
            v4u* op = (v4u*)(outraw + (size_t)m * RV + hh * 512) + lane;
            const v4u ov = *op; const v4u gvv = *((const v4u*)(proj + (size_t)m * NPROJ + 4096 + hh * 512) + lane);
            float o[8] = {bflo(ov.x), bfhi(ov.x), bflo(ov.y), bfhi(ov.y), bflo(ov.z), bfhi(ov.z), bflo(ov.w), bfhi(ov.w)};
            float g[8] = {bflo(gvv.x), bfhi(gvv.x), bflo(gvv.y), bfhi(gvv.y), bflo(gvv.z), bfhi(gvv.z), bflo(gvv.w), bfhi(gvv.w)};
            float s = 0.f;
#pragma unroll
            for (int e = 0; e < 8; ++e) s += o[e] * o[e];
            const float rstd = 1.0f / sqrtf(wave_sum(s) * (1.f / 512.f) + EPS);
            v4u w; w.x = pk2(o[0] * rstd * g[0], o[1] * rstd * g[1]); w.y = pk2(o[2] * rstd * g[2], o[3] * rstd * g[3]);
            w.z = pk2(o[4] * rstd * g[4], o[5] * rstd * g[5]); w.w = pk2(o[6] * rstd * g[6], o[7] * rstd * g[7]);
            *op = w;
        }
    }
}
DI void combine_rows(const bf16* O0, const bf16* O1, const float* lamp, float lambda_init, bf16* on, int gw, int NGW, int lane) {
    const float a = lamp[lane] * lamp[64 + lane], b = lamp[128 + lane] * lamp[192 + lane];
    const float lam = expf(wave_sum(a)) - expf(wave_sum(b)) + lambda_init;
    for (int m = gw; m < M; m += NGW) {
        const v4u* p0 = (const v4u*)(O0 + (size_t)m * D) + 2 * lane; const v4u* p1 = (const v4u*)(O1 + (size_t)m * D) + 2 * lane;
        const v4u a0 = p0[0], a1 = p0[1], b0 = p1[0], b1 = p1[1];
        const unsigned aw[8] = {a0.x, a0.y, a0.z, a0.w, a1.x, a1.y, a1.z, a1.w}, bw[8] = {b0.x, b0.y, b0.z, b0.w, b1.x, b1.y, b1.z, b1.w};
        float o[16]; float s = 0.f;
#pragma unroll
        for (int e = 0; e < 8; ++e) { o[2 * e] = bflo(aw[e]) - lam * bflo(bw[e]); o[2 * e + 1] = bfhi(aw[e]) - lam * bfhi(bw[e]); s += o[2 * e] * o[2 * e] + o[2 * e + 1] * o[2 * e + 1]; }
        s += __shfl_xor(s, 1); s += __shfl_xor(s, 2); s += __shfl_xor(s, 4);
        const float rstd = 1.0f / sqrtf(s * (1.f / 128.f) + EPS);
        v4u w0, w1; w0.x = pk2(o[0] * rstd, o[1] * rstd); w0.y = pk2(o[2] * rstd, o[3] * rstd); w0.z = pk2(o[4] * rstd, o[5] * rstd); w0.w = pk2(o[6] * rstd, o[7] * rstd);
        w1.x = pk2(o[8] * rstd, o[9] * rstd); w1.y = pk2(o[10] * rstd, o[11] * rstd); w1.z = pk2(o[12] * rstd, o[13] * rstd); w1.w = pk2(o[14] * rstd, o[15] * rstd);
        v4u* op = (v4u*)(on + (size_t)m * D) + 2 * lane; op[0] = w0; op[1] = w1;
    }
}
DI void conv_rows(bf16* up, const bf16* side, const float* cw, const float* cb, int G, int vb, int tid) {
    if (tid >= FF / 8) return;
    const int c0 = tid * 8;
    float wg[3][8], wu[3][8], bg[8], bu[8];
#pragma unroll
    for (int j = 0; j < 3; ++j)
#pragma unroll
        for (int e = 0; e < 8; ++e) { wg[j][e] = cw[j * FF2 + c0 + e]; wu[j][e] = cw[j * FF2 + FF + c0 + e]; }
#pragma unroll
    for (int e = 0; e < 8; ++e) { bg[e] = cb[c0 + e]; bu[e] = cb[FF + c0 + e]; }
    for (int blk = vb; blk < M / 64; blk += G) {
        const int t0 = blk * 64;
        float g2[8], g1[8], u2[8], u1[8];
        if ((t0 & (SEQ - 1)) == 0) {
#pragma unroll
            for (int e = 0; e < 8; ++e) { g2[e] = 0.f; g1[e] = 0.f; u2[e] = 0.f; u1[e] = 0.f; }
        } else {
            const v4u a = *(const v4u*)(side + (size_t)((blk - 1) * 2 + 0) * FF + c0), b = *(const v4u*)(side + (size_t)((blk - 1) * 2 + 1) * FF + c0);
            const v4u c = *(const v4u*)(up + (size_t)(t0 - 2) * FF2 + FF + c0), d = *(const v4u*)(up + (size_t)(t0 - 1) * FF2 + FF + c0);
            const unsigned aw[4] = {a.x, a.y, a.z, a.w}, bw[4] = {b.x, b.y, b.z, b.w}, cw4[4] = {c.x, c.y, c.z, c.w}, dw[4] = {d.x, d.y, d.z, d.w};
#pragma unroll
            for (int e = 0; e < 4; ++e) { g2[2 * e] = bflo(aw[e]); g2[2 * e + 1] = bfhi(aw[e]); g1[2 * e] = bflo(bw[e]); g1[2 * e + 1] = bfhi(bw[e]);
                u2[2 * e] = bflo(cw4[e]); u2[2 * e + 1] = bfhi(cw4[e]); u1[2 * e] = bflo(dw[e]); u1[2 * e + 1] = bfhi(dw[e]); }
        }
        for (int t = t0; t < t0 + 64; t += 4) {
            v4u gr[4], ur[4];
#pragma unroll
            for (int i = 0; i < 4; ++i) { gr[i] = *(const v4u*)(up + (size_t)(t + i) * FF2 + c0); ur[i] = *(const v4u*)(up + (size_t)(t + i) * FF2 + FF + c0); }
#pragma unroll
            for (int i = 0; i < 4; ++i) {
                const unsigned gw4[4] = {gr[i].x, gr[i].y, gr[i].z, gr[i].w}, uw4[4] = {ur[i].x, ur[i].y, ur[i].z, ur[i].w};
                float gc[8], uc[8], act[8];
#pragma unroll
                for (int e = 0; e < 4; ++e) { gc[2 * e] = bflo(gw4[e]); gc[2 * e + 1] = bfhi(gw4[e]); uc[2 * e] = bflo(uw4[e]); uc[2 * e + 1] = bfhi(uw4[e]); }
#pragma unroll
                for (int e = 0; e < 8; ++e) {
                    const float hg = bg[e] + wg[0][e] * g2[e] + wg[1][e] * g1[e] + wg[2][e] * gc[e];
                    const float hu = bu[e] + wu[0][e] * u2[e] + wu[1][e] * u1[e] + wu[2][e] * uc[e];
                    act[e] = hg * __builtin_amdgcn_rcpf(1.0f + __expf(-hg)) * hu;
                    g2[e] = g1[e]; g1[e] = gc[e]; u2[e] = u1[e]; u1[e] = uc[e];
                }
                v4u w; w.x = pk2(act[0], act[1]); w.y = pk2(act[2], act[3]); w.z = pk2(act[4], act[5]); w.w = pk2(act[6], act[7]);
                *(v4u*)(up + (size_t)(t + i) * FF2 + c0) = w;
            }
        }
    }
}

DI bf16x8 tr_frag(LAS const unsigned char* lo, int hi_off) {
    const v4i16 a = __builtin_amdgcn_ds_read_tr16_b64_v4i16((LAS v4i16*)lo);
    const v4i16 b = __builtin_amdgcn_ds_read_tr16_b64_v4i16((LAS v4i16*)(lo + hi_off));
    return (bf16x8){a[0], a[1], a[2], a[3], b[0], b[1], b[2], b[3]};
}
#define MFMA16(a, b, c) __builtin_amdgcn_mfma_f32_16x16x32_bf16((a), (b), (c), 0, 0, 0)
DI void retention_phase(LAS unsigned char* lds, const bf16* proj, bf16* outraw, int G, int vcu) {
    const int tid = threadIdx.x, lane = tid & 63, wid = __builtin_amdgcn_readfirstlane(tid >> 6);
    const int fr = lane & 15, fq = lane >> 4, q = fr >> 2, p = fr & 3;
    const int rb = wid < 4 ? wid : 11 - wid;
    constexpr int KROW = 528, VROW = 144, SROW = 144;
    constexpr int KS_OFF = 0, VS_OFF = 128 * KROW, SS_OFF = VS_OFF + 128 * VROW;
    static_assert(SS_OFF + 256 * SROW <= RING_BYTES, "retention LDS");
    LAS unsigned char* KS = lds + KS_OFF; LAS unsigned char* VS = lds + VS_OFF; LAS unsigned char* SS = lds + SS_OFF;
    for (int item = vcu; item < 256; item += G) {
        const int b = item >> 5, h = (item >> 3) & 3, es = item & 7;
        const float l2g = log2f(1.0f - exp2f(-5.0f - (float)h));
        const float cd = exp2f(l2g * 128.0f);
        for (int i = tid; i < 256 * SROW / 4; i += NWAVES * 64) ((LAS unsigned*)SS)[i] = 0u;
        f32x4 st[2][4];
#pragma unroll
        for (int mi = 0; mi < 2; ++mi)
#pragma unroll
            for (int nb = 0; nb < 4; ++nb) st[mi][nb] = (f32x4){0.f, 0.f, 0.f, 0.f};
        const bf16* Qg = proj + (size_t)(b * SEQ) * NPROJ + h * 256;
        const bf16* Kg = Qg + 1024;
        const bf16* Vg = proj + (size_t)(b * SEQ) * NPROJ + 2048 + h * 512 + es * 64;
        bf16* Og = outraw + (size_t)(b * SEQ) * RV + h * 512 + es * 64;
        for (int c = 0; c < 16; ++c) {
#pragma unroll
            for (int i = 0; i < 8; ++i) { const int pc = tid + 512 * i, row = pc >> 5, c16 = pc & 31;
                const v4u v = *(const v4u*)(Kg + (size_t)(c * 128 + row) * NPROJ + c16 * 8);
                *(LAS v4u*)(KS + row * KROW + c16 * 16) = v; }
#pragma unroll
            for (int i = 0; i < 2; ++i) { const int pc = tid + 512 * i, row = pc >> 3, c16 = pc & 7;
                const v4u v = *(const v4u*)(Vg + (size_t)(c * 128 + row) * NPROJ + c16 * 8);
                const float kd = exp2f(l2g * (float)(127 - row));
                v4u w; w.x = pk2(bflo(v.x) * kd, bfhi(v.x) * kd); w.y = pk2(bflo(v.y) * kd, bfhi(v.y) * kd); w.z = pk2(bflo(v.z) * kd, bfhi(v.z) * kd); w.w = pk2(bflo(v.w) * kd, bfhi(v.w) * kd);
                *(LAS v4u*)(VS + row * VROW + c16 * 16) = w; }
            bf16x8 Qf[8];
#pragma unroll
            for (int ks = 0; ks < 8; ++ks) Qf[ks] = *(const bf16x8*)(Qg + (size_t)(c * 128 + 16 * rb + fr) * NPROJ + ks * 32 + fq * 8);
            __syncthreads();
            f32x4 ao[4];
#pragma unroll
            for (int nb = 0; nb < 4; ++nb) ao[nb] = (f32x4){0.f, 0.f, 0.f, 0.f};
#pragma unroll
            for (int ks = 0; ks < 8; ++ks)
#pragma unroll
                for (int nb = 0; nb < 4; ++nb) { const bf16x8 B = tr_frag(SS + (32 * ks + 8 * fq + q) * SROW + (16 * nb + 4 * p) * 2, 4 * SROW); ao[nb] = MFMA16(Qf[ks], B, ao[nb]); }
#pragma unroll
            for (int kp = 0; kp < 4; ++kp) {
                if (2 * kp <= rb) {
                    f32x4 s0 = (f32x4){0.f, 0.f, 0.f, 0.f}, s1 = (f32x4){0.f, 0.f, 0.f, 0.f};
#pragma unroll
                    for (int ks = 0; ks < 8; ++ks) { const bf16x8 A = *(const LAS bf16x8*)(KS + (32 * kp + fr) * KROW + (32 * ks + 8 * fq) * 2); s0 = MFMA16(A, Qf[ks], s0); }
                    if (2 * kp == rb) {
#pragma unroll
                        for (int jj = 0; jj < 4; ++jj) if (4 * fq + jj > fr) s0[jj] = 0.f;
                    }
                    if (2 * kp + 1 <= rb) {
#pragma unroll
                        for (int ks = 0; ks < 8; ++ks) { const bf16x8 A = *(const LAS bf16x8*)(KS + (32 * kp + 16 + fr) * KROW + (32 * ks + 8 * fq) * 2); s1 = MFMA16(A, Qf[ks], s1); }
                        if (2 * kp + 1 == rb) {
#pragma unroll
                            for (int jj = 0; jj < 4; ++jj) if (4 * fq + jj > fr) s1[jj] = 0.f;
                        }
                    }
                    v4u pw; pw.x = pk2(s0[0], s0[1]); pw.y = pk2(s0[2], s0[3]); pw.z = pk2(s1[0], s1[1]); pw.w = pk2(s1[2], s1[3]);
                    const bf16x8 Pa = __builtin_bit_cast(bf16x8, pw);
#pragma unroll
                    for (int nb = 0; nb < 4; ++nb) { const bf16x8 B = tr_frag(VS + (32 * kp + 4 * fq + q) * VROW + (16 * nb + 4 * p) * 2, 16 * VROW); ao[nb] = MFMA16(Pa, B, ao[nb]); }
                }
            }
#pragma unroll
            for (int jj = 0; jj < 4; ++jj) { const int il = 16 * rb + 4 * fq + jj; const float sc = exp2f(l2g * (float)(il - 127));
                bf16* orow = Og + (size_t)(c * 128 + il) * RV + fr;
#pragma unroll
                for (int nb = 0; nb < 4; ++nb) orow[16 * nb] = (bf16)(pk2(ao[nb][jj] * sc, 0.f) & 0xffffu); }
#pragma unroll
            for (int mi = 0; mi < 2; ++mi)
#pragma unroll
                for (int nb = 0; nb < 4; ++nb) st[mi][nb] = st[mi][nb] * cd;
#pragma unroll
            for (int ks = 0; ks < 4; ++ks) {
                bf16x8 A[2], B[4];
#pragma unroll
                for (int mi = 0; mi < 2; ++mi) A[mi] = tr_frag(KS + (32 * ks + 8 * fq + q) * KROW + (16 * (2 * wid + mi) + 4 * p) * 2, 4 * KROW);
#pragma unroll
                for (int nb = 0; nb < 4; ++nb) B[nb] = tr_frag(VS + (32 * ks + 8 * fq + q) * VROW + (16 * nb + 4 * p) * 2, 4 * VROW);
#pragma unroll
                for (int mi = 0; mi < 2; ++mi)
#pragma unroll
                    for (int nb = 0; nb < 4; ++nb) st[mi][nb] = MFMA16(A[mi], B[nb], st[mi][nb]);
            }
            __syncthreads();
            if (c < 15) {
#pragma unroll
                for (int mi = 0; mi < 2; ++mi)
#pragma unroll
                    for (int nb = 0; nb < 4; ++nb)
#pragma unroll
                        for (int jj = 0; jj < 4; ++jj)
                            *(LAS unsigned short*)(SS + (16 * (2 * wid + mi) + 4 * fq + jj) * SROW + (16 * nb + fr) * 2) = (unsigned short)(pk2(st[mi][nb][jj] * cd, 0.f) & 0xffffu);
            }
        }
    }
}

typedef GAS unsigned gu32;
#define RLX_AGENT __ATOMIC_RELAXED, __HIP_MEMORY_SCOPE_AGENT
#define XB_TMO      128
#define XB_XCNT(j)  (256  + 64 * (j))
#define XB_XSUB(j)  (1280 + 64 * (j))
#define XB_XGEN(j)  (2304 + 64 * (j))
#define XB_TOP      3328
#define XB_TOPGEN   3392
#define XCD_BAR_WORDS 3456
#define XB_SPIN_CAP (1u << 18)

__device__ __forceinline__ unsigned xb_ld(unsigned* p)              { return __hip_atomic_load(p, __ATOMIC_RELAXED, __HIP_MEMORY_SCOPE_AGENT); }
__device__ __forceinline__ unsigned xb_add(unsigned* p, unsigned v) { return __hip_atomic_fetch_add(p, v, __ATOMIC_RELAXED, __HIP_MEMORY_SCOPE_AGENT); }
__device__ __forceinline__ unsigned xb_xcc_id() { return (unsigned)__builtin_amdgcn_s_getreg((3 << 11) | 20) & 0xFu; }
#define XB_SPIN(cond, bar) do { unsigned _sp = 0; while (cond) { __builtin_amdgcn_s_sleep(1); \
    if ((++_sp & 255u) == 0u) { if (xb_ld(&(bar)[XB_TMO])) break; if (_sp > XB_SPIN_CAP) { atomicAdd(&(bar)[XB_TMO], 1u); break; } } } } while (0)

struct XcdBarrier {
    unsigned* bar; unsigned x;
    volatile LAS unsigned* st;
};

__device__ __forceinline__ XcdBarrier xcd_barrier_post(unsigned* bar, volatile LAS unsigned* st) {
    XcdBarrier b; b.bar = bar; b.x = xb_xcc_id(); b.st = st;
    if (threadIdx.x == 0) (void)xb_add(&bar[XB_XCNT(b.x)], 1u);
    return b;
}
__device__ __forceinline__ void xcd_barrier_complete(unsigned* bar, unsigned x, unsigned& nloc, unsigned& nx) {
    const unsigned G = gridDim.x * gridDim.y * gridDim.z;
    unsigned sum, cnt, mine, sp = 0u;
    for (;;) {
        sum = 0u; cnt = 0u; mine = 0u;
#pragma unroll
        for (unsigned j = 0; j < 16; ++j) { const unsigned c = xb_ld(&bar[XB_XCNT(j)]); sum += c; cnt += (c > 0u) ? 1u : 0u; mine = (j == x) ? c : mine; }
        if (sum == G) break;
        __builtin_amdgcn_s_sleep(1);
        if ((++sp & 255u) == 0u) { if (xb_ld(&bar[XB_TMO])) break; if (sp > XB_SPIN_CAP) { atomicAdd(&bar[XB_TMO], 1u); break; } }
    }
    nloc = mine > 0u ? mine : 1u; nx = cnt > 0u ? cnt : 1u;
}

__device__ __forceinline__ void xcd_barrier(const XcdBarrier& b) {
    asm volatile("s_waitcnt vmcnt(0)" ::: "memory");
    __syncthreads();
    if (threadIdx.x == 0) {
        unsigned* bar = b.bar;
        __builtin_amdgcn_s_waitcnt(0);
        unsigned nloc = b.st[0], nx = b.st[1];
        if (nloc == 0u) { xcd_barrier_complete(bar, b.x, nloc, nx); b.st[0] = nloc; b.st[1] = nx; }
        const unsigned old = xb_add(&bar[XB_XSUB(b.x)], 1u);
        const unsigned gen = old / nloc;
        if (old + 1u == (gen + 1u) * nloc) {
            __builtin_amdgcn_fence(__ATOMIC_RELEASE, "agent");
            asm volatile("s_waitcnt vmcnt(0)" ::: "memory");
            const unsigned og = xb_add(&bar[XB_TOP], 1u);
            const unsigned tg = og / nx;
            if (og + 1u == (tg + 1u) * nx) xb_add(&bar[XB_TOPGEN], 1u);
            else XB_SPIN(xb_ld(&bar[XB_TOPGEN]) == tg, bar);
            __builtin_amdgcn_fence(__ATOMIC_ACQUIRE, "agent");
            xb_add(&bar[XB_XGEN(b.x)], 1u);
            asm volatile("s_waitcnt vmcnt(0)" ::: "memory");
        } else {
            XB_SPIN(xb_ld(&bar[XB_XGEN(b.x)]) == gen, bar);
            __builtin_amdgcn_fence(__ATOMIC_ACQUIRE, "agent");
            asm volatile("s_waitcnt vmcnt(0)" ::: "memory");
        }
    }
    __syncthreads();
}
constexpr int CW_BAR = 4096, MISC_OFF = RING_BYTES + 512;
constexpr int PTR_OFF = RING_BYTES + 1024;
DI const float* inptr(LAS unsigned char* lds, int k) {
    volatile LAS unsigned* t = (volatile LAS unsigned*)(lds + PTR_OFF);
    const unsigned lo = __builtin_amdgcn_readfirstlane(t[2 * k]), hi = __builtin_amdgcn_readfirstlane(t[2 * k + 1]);
    return (const float*)(((unsigned long long)hi << 32) | (unsigned long long)lo);
}
#define PH_IDS int tid = threadIdx.x; asm volatile("" : "+v"(tid)); const int lane = tid & 63, wave = __builtin_amdgcn_readfirstlane(tid >> 6); \
    const int gw = vcu * NWAVES + wave, NGW = G * NWAVES; (void)lane; (void)gw; (void)NGW;
#define WPTR(off) ((bf16*)(ws + (off)))

#define FFN_PHASES(L, pb) \
        if (IN(pb)) { \
            pg8::Gemm g{(const bf16*)(ws + B_XN), WPTR(WS_WC), M, FF2, D, D}; pg8::StaticOrder S; S.init(M, FF2, G, bx); \
            pg8::EpiOut E{(bf16*)(ws + B_UP), FF2, 0, 0, 1.f, (bf16*)(ws + B_SIDE), FF / 256, FF}; \
            pg8::gemm_phase<pg8::EpiOut, pg8::StaticOrder, true, true>(lds + RING_OFF, g, S, E); \
        } \
        SEAM(pb); \
        if (IN(pb + 1)) { PH_IDS \
            conv_rows((bf16*)(ws + B_UP), (const bf16*)(ws + B_SIDE), inptr(lds, 16) + (size_t)L * 3 * FF2, inptr(lds, 17) + (size_t)L * FF2, G, vcu, tid); \
            if (L == 0) convert_matrix(inptr(lds, 15) + (size_t)D * FF2, D, FF2, WPTR(WS_WC), 0, inptr(lds, 13) + D, D, 1.f, lds, gw, NGW, wave, lane); \
            __syncthreads(); \
        } \
        SEAM(pb + 1); \
        if (IN(pb + 2)) { \
            pg8::Gemm g{(const bf16*)(ws + B_UP), WPTR(WS_WD), M, D, FF, FF2}; pg8::StaticOrder S; S.init(M, D, G, bx); \
            pg8::EpiOut E{(bf16*)(ws + B_XN), D, 0, 0, 1.f, nullptr, 0, 0}; \
            pg8::gemm_phase<pg8::EpiOut, pg8::StaticOrder, true, true>(lds + RING_OFF, g, S, E); \
        } \
        SEAM(pb + 2); \
        if (IN(pb + 3)) { PH_IDS \
            resid_rows((const bf16*)(ws + B_XN), out, inptr(lds, 14) + (size_t)L * D, out, L == 0 ? (bf16*)(ws + B_XN2) : (bf16*)nullptr, gw, NGW, lane); \
            if (L == 0) convert_matrix(inptr(lds, 18) + (size_t)FF * D, FF, D, WPTR(WS_WD), 0, nullptr, FF, 1.f, lds, gw, NGW, wave, lane); \
            __syncthreads(); \
        }
struct Args { const float* in[19]; float* out; unsigned char* ws; int ph_lo, ph_hi; float lambda_init; int pad; };
__global__ void __launch_bounds__(NWAVES * 64, 2) yoco_fwd(Args args) {
    extern __shared__ __attribute__((aligned(16))) unsigned char lds_raw[];
    LAS unsigned char* lds = (LAS unsigned char*)lds_raw;
    cg::grid_group grid = cg::this_grid();
    const int G = gridDim.x; const int bx = blockIdx.x;
    const int vcu = (G % 8 == 0) ? (bx % 8) * (G / 8) + bx / 8 : bx;
    unsigned char* ws = args.ws;
    float* out = args.out;
    const int lo = args.ph_lo, hi = args.ph_hi;
    { const int t0 = threadIdx.x; if (t0 < 19) ((LAS unsigned long long*)(lds + PTR_OFF))[t0] = (unsigned long long)args.in[t0]; }
    if (threadIdx.x < 2) ((volatile LAS unsigned*)(lds + MISC_OFF))[threadIdx.x] = 0u;
    __syncthreads();
    XcdBarrier xbar; xbar.bar = (unsigned*)(ws + WS_CTL) + CW_BAR; xbar.x = 0; xbar.st = nullptr;
    if (N_LAUNCHES == 1) xbar = xcd_barrier_post((unsigned*)(ws + WS_CTL) + CW_BAR, (volatile LAS unsigned*)(lds + MISC_OFF));
#ifndef PHMASK
#define PHMASK 0x7ffff
#endif
#define IN(k) (((PHMASK >> ((k) > 14 ? (k) - 9 : (k))) & 1) && lo <= (k) && (k) < hi)
#define SEAM(k) do { if (IN(k) && IN((k) + 1)) { if ((k) == 0) grid.sync(); else xcd_barrier(xbar); } } while (0)

    if (IN(0)) { PH_IDS
        float* cosT = (float*)(ws + WS_COS); float* sinT = (float*)(ws + WS_SIN);
        for (int i = (vcu * NWAVES * 64 + tid); i < SEQ * 128; i += G * NWAVES * 64) { const int pos = i >> 7, j = i & 127;
            const float inv = 1.0f / exp2f(13.287712379549449f * ((float)j / 127.0f)); const float ang = (float)pos * inv;
            const double rev = (double)ang * 0.15915494309189535; const float fr = (float)(rev - floor(rev));
            cosT[i] = __builtin_amdgcn_cosf(fr); sinT[i] = __builtin_amdgcn_sinf(fr); }
        convert_matrix(inptr(lds, 3), D, NPROJ, WPTR(WS_WA), 0, inptr(lds, 1), D, 1.f, lds, gw, NGW, wave, lane);
        convert_matrix(inptr(lds, 4), RV, D, WPTR(WS_WB), 0, nullptr, RV, 1.f, lds, gw, NGW, wave, lane);
        convert_matrix(inptr(lds, 15), D, FF2, WPTR(WS_WC), 0, inptr(lds, 13), D, 1.f, lds, gw, NGW, wave, lane);
        convert_matrix(inptr(lds, 18), FF, D, WPTR(WS_WD), 0, nullptr, FF, 1.f, lds, gw, NGW, wave, lane);
        norm_rows(inptr(lds, 0), (bf16*)out, gw, NGW, lane);
        __syncthreads();
    }
    SEAM(0);
    if (IN(1)) {
        pg8::Gemm g{(const bf16*)out, WPTR(WS_WA), M, NPROJ, D, D}; pg8::StaticOrder S; S.init(M, NPROJ, G, bx);
        pg8::EpiProj E{(bf16*)(ws + B_PROJ), NPROJ, (const float*)(ws + WS_COS), (const float*)(ws + WS_SIN)};
        pg8::gemm_phase<pg8::EpiProj, pg8::StaticOrder, true, true>(lds + RING_OFF, g, S, E);
    }
    SEAM(1);
    if (IN(2)) { retention_phase(lds + RING_OFF, (const bf16*)(ws + B_PROJ), (bf16*)out, G, vcu); __syncthreads(); }
    SEAM(2);
    if (IN(3)) { PH_IDS
        y_rows((bf16*)out, (const bf16*)(ws + B_PROJ), gw, NGW, lane);
        convert_matrix(inptr(lds, 9), D, D, WPTR(WS_WA), 0, inptr(lds, 7), D, 1.f, lds, gw, NGW, wave, lane);
        convert_matrix(inptr(lds, 6), D, 2 * D, WPTR(WS_WA), D, inptr(lds, 5), D, 1.f, lds, gw, NGW, wave, lane);
        convert_matrix(inptr(lds, 12), D, D, WPTR(WS_WA + 8 * MiB), 0, inptr(lds, 11), 128, 1.0f - args.lambda_init, lds, gw, NGW, wave, lane);
        __syncthreads();
    }
    SEAM(3);
    if (IN(4)) {
        pg8::Gemm g{(const bf16*)out, WPTR(WS_WB), M, D, RV, RV}; pg8::StaticOrder S; S.init(M, D, G, bx);
        pg8::EpiOut E{(bf16*)(ws + B_H), D, 0, 0, 1.f, nullptr, 0, 0};
        pg8::gemm_phase<pg8::EpiOut, pg8::StaticOrder, true, true>(lds + RING_OFF, g, S, E);
    }
    SEAM(4);
    if (IN(5)) { PH_IDS resid_rows((const bf16*)(ws + B_H), inptr(lds, 0), inptr(lds, 2), out, (bf16*)(ws + B_XN), gw, NGW, lane); }
    SEAM(5);
    FFN_PHASES(0, 6)
    SEAM(9);
    if (IN(10)) {
        pg8::Gemm g{(const bf16*)(ws + B_XN2), WPTR(WS_WA), M, 3 * D, D, D}; pg8::StaticOrder S; S.init(M, 3 * D, G, bx);
        pg8::EpiOut E{(bf16*)(ws + B_QKV), D, D, (size_t)M * D, attn_body::C2, nullptr, 0, 0};
        pg8::gemm_phase<pg8::EpiOut, pg8::StaticOrder, true, true>(lds + RING_OFF, g, S, E);
    }
    SEAM(10);
    if (IN(11)) {
        const attn_body::bf16* Qp = (const attn_body::bf16*)(ws + B_QKV);
        const attn_body::AttnTensors AT{Qp, Qp + (size_t)M * D, Qp + (size_t)2 * M * D, (attn_body::bf16*)(ws + B_O0), (attn_body::bf16*)(ws + B_O1)};
        const attn_body::StaticOrder S((int)G, (int)bx);
        attn_body::attn_phase<attn_body::StaticOrder>((char*)lds_raw + RING_OFF, AT, S);
        __syncthreads();
    }
    SEAM(11);
    if (IN(12)) { PH_IDS combine_rows((const bf16*)(ws + B_O0), (const bf16*)(ws + B_O1), inptr(lds, 10), args.lambda_init, (bf16*)(ws + B_ON), gw, NGW, lane); }
    SEAM(12);
    if (IN(13)) {
        pg8::Gemm g{(const bf16*)(ws + B_ON), WPTR(WS_WA + 8 * MiB), M, D, D, D}; pg8::StaticOrder S; S.init(M, D, G, bx);
        pg8::EpiOut E{(bf16*)(ws + B_H2), D, 0, 0, 1.f, nullptr, 0, 0};
        pg8::gemm_phase<pg8::EpiOut, pg8::StaticOrder, true, true>(lds + RING_OFF, g, S, E);
    }
    SEAM(13);
    if (IN(14)) { PH_IDS resid_rows((const bf16*)(ws + B_H2), out, inptr(lds, 8), out, (bf16*)(ws + B_XN), gw, NGW, lane); }
    SEAM(14);
    FFN_PHASES(1, 15)
#undef IN
#undef SEAM
}

extern "C" void kernel_launch(void* const* d_in, const int* in_sizes, int n_in, void* d_out, int out_size, void* d_ws, size_t ws_size, hipStream_t stream) {
    static int grid = 0;
    if (grid == 0) {
        if (n_in != 19 || in_sizes[0] != M * D || out_size != M * D || ws_size < WS_END) { fprintf(stderr, "kernel_launch: unexpected shapes (n_in %d, in0 %d, out %d, ws %zu); nothing launched\n", n_in, n_in > 0 ? in_sizes[0] : -1, out_size, ws_size); grid = -1; return; }
        int dev = 0, cus = 0, per_cu = 0;
        if (hipGetDevice(&dev) != hipSuccess || hipDeviceGetAttribute(&cus, hipDeviceAttributeMultiprocessorCount, dev) != hipSuccess) { grid = -1; return; }
        if (hipFuncSetAttribute((const void*)yoco_fwd, hipFuncAttributeMaxDynamicSharedMemorySize, LDS_BYTES) != hipSuccess) { fprintf(stderr, "kernel_launch: hipFuncSetAttribute failed\n"); grid = -1; return; }
        if (hipOccupancyMaxActiveBlocksPerMultiprocessor(&per_cu, (const void*)yoco_fwd, NWAVES * 64, LDS_BYTES) != hipSuccess || per_cu < 1) { fprintf(stderr, "kernel_launch: occupancy query says %d\n", per_cu); per_cu = 1; }
        (void)hipGetLastError();
        grid = cus;
    }
    if (grid < 0) return;
    if (hipMemsetAsync((char*)d_ws + WS_CTL, 0, 65536, stream) != hipSuccess) { fprintf(stderr, "kernel_launch: hipMemsetAsync failed\n"); return; }
    Args a{};
    for (int i = 0; i < 19; ++i) a.in[i] = (const float*)d_in[i];
    a.out = (float*)d_out; a.ws = (unsigned char*)d_ws;
    a.lambda_init = (float)(0.8 - 0.6 * exp(-0.3 * 1.0));
    if (N_LAUNCHES == 1) {
        a.ph_lo = 0; a.ph_hi = NPHASE;
        void* kargs[] = {&a};
        hipError_t e = hipLaunchCooperativeKernel((const void*)yoco_fwd, dim3(grid), dim3(NWAVES * 64), kargs, LDS_BYTES, stream);
        if (e != hipSuccess) fprintf(stderr, "kernel_launch: cooperative launch failed: %s (grid %d)\n", hipGetErrorString(e), grid);
    } else {
        for (int p = 0; p < NPHASE; ++p) {
            a.ph_lo = p; a.ph_hi = p + 1;
            hipLaunchKernelGGL(yoco_fwd, dim3(grid), dim3(NWAVES * 64), LDS_BYTES, stream, a);
            const hipError_t le = hipPeekAtLastError();
            if (le != hipSuccess) { fprintf(stderr, "kernel_launch: launch %d failed: %s\n", p, hipGetErrorName(le)); break; }
        }
    }
}
```

```cpp
#include <hip/hip_runtime.h>
#include <hip/hip_bf16.h>
#include <hip/hip_cooperative_groups.h>
#include <cstdio>
#include <cstdint>
#include <cmath>
namespace cg = cooperative_groups;

#ifndef MK_N_LAUNCHES
#define MK_N_LAUNCHES 1
#endif

namespace pg8 {
#define PG8_LAS __attribute__((address_space(3)))
typedef unsigned short bf16_t;
typedef short bf16x8 __attribute__((ext_vector_type(8)));
typedef float f32x4 __attribute__((ext_vector_type(4)));
typedef unsigned u32x4 __attribute__((ext_vector_type(4)));
constexpr int BM = 256, BK = 64, HALF = 128, HTB = HALF * BK * 2  , STAGE_BYTES = 8 * HTB, NXCD = 8, WGM = 8;

__host__ __device__ __forceinline__ int lds_byte(int r, int c) { const int st = (r >> 4) * 2 + (c >> 5), rr = r & 15, cc = c & 31, ob = rr * 64 + cc * 2; return st * 1024 + (ob ^ (((ob >> 9) & 1) << 5)); }
__host__ __device__ __forceinline__ void stage_rc(int b, int& R, int& C) { const int st = b / 1024, sb = b % 1024, swz = sb ^ (((sb >> 9) & 1) << 5); R = (st >> 1) * 16 + swz / 64; C = (st & 1) * 32 + (swz % 64) / 2; }
__host__ __device__ __forceinline__ int perm32(int rho) { const int n = rho >> 4, i = rho & 15; return 8 * (i >> 2) + 4 * n + (i & 3); }

struct Unit { int pm, pn; };
struct Gemm { const bf16_t* A; const bf16_t* Bt; int M, N, K, lda; };

struct StaticOrder {
    int nM, nN, nwg, G, c;
    __host__ __device__ void init(int M, int N, int G_, int c_) { nM = M / BM; nN = N / BM; nwg = nM * nN; G = G_; c = c_; }
    __host__ __device__ bool next(int i, Unit& u) const {
        const long L = (long)i * G + c; if (L >= nwg) return false;
        int wgid = (int)L; { const int q = nwg / NXCD, r = nwg % NXCD, xcd = wgid % NXCD, off = wgid / NXCD; wgid = (xcd < r ? xcd * (q + 1) : r * (q + 1) + (xcd - r) * q) + off; }
        const int nig = WGM * nN, gid = wgid / nig, fm = gid * WGM, gsz = (nM - fm) < WGM ? (nM - fm) : WGM;
        u.pm = fm + ((wgid % nig) % gsz); u.pn = (wgid % nig) / gsz; return true;
    }
    __device__ __forceinline__ void a_ready(const Unit&) const {}
    __device__ __forceinline__ void done(const Unit&) const {}
};

__device__ __forceinline__ unsigned cvt_pk_bf16(float lo, float hi) { unsigned r; asm volatile("v_cvt_pk_bf16_f32 %0, %1, %2" : "=v"(r) : "v"(lo), "v"(hi)); return r; }

struct EpiOut {
    static constexpr bool PERM = true, AFTER_DRAIN = false;
    bf16_t* O; int ldc; int split_cols; size_t split_stride; float scale0; bf16_t* side; int side_pn; int side_ld;
    __device__ __forceinline__ void operator()(const f32x4 (&acc)[2][2][4][2], const Unit& u, int wr, int wc, int fr, int fq) const {
        const int row0 = u.pm * BM + wr * 64 + fr; int colt = u.pn * BM; bf16_t* base = O;
        float sc = 1.f; if (split_cols) { const int t = colt / split_cols; base += (size_t)t * split_stride; colt -= t * split_cols; if (t == 0) sc = scale0; }
        const int col0 = colt + wc * 32 + 8 * fq;
        const bool do_side = (side != nullptr) && (u.pn < side_pn);
#pragma unroll
        for (int ai = 0; ai < 2; ++ai)
#pragma unroll
            for (int m = 0; m < 4; ++m) { const int row = row0 + ai * HALF + m * 16; bf16_t* rowp = base + (size_t)row * ldc + col0;
#pragma unroll
                for (int bj = 0; bj < 2; ++bj) { f32x4 v0 = acc[ai][bj][m][0] * sc, v1 = acc[ai][bj][m][1] * sc;
                    u32x4 w; w.x = cvt_pk_bf16(v0[0], v0[1]); w.y = cvt_pk_bf16(v0[2], v0[3]); w.z = cvt_pk_bf16(v1[0], v1[1]); w.w = cvt_pk_bf16(v1[2], v1[3]);
                    *(u32x4*)(rowp + bj * HALF) = w;
                    if (m == 3) { if (do_side && fr >= 14) *(u32x4*)(side + (size_t)((row >> 6) * 2 + (fr - 14)) * side_ld + col0 + bj * HALF) = w; } } }
    }
};

struct EpiProj {
    static constexpr bool PERM = true, AFTER_DRAIN = false;
    bf16_t* O; int ldc; const float* cosT; const float* sinT;
    __device__ __forceinline__ void operator()(const f32x4 (&acc)[2][2][4][2], const Unit& u, int wr, int wc, int fr, int fq) const {
        const int row0 = u.pm * BM + wr * 64 + fr; const int colt = u.pn * BM; const int j0 = wc * 32 + 8 * fq; const int col0 = colt + j0;
        const int kind = u.pn < 8 ? 0 : (u.pn < 16 ? 1 : 2);
        const float ksc = (u.pn >= 4) ? 0.0625f : 1.0f;
#pragma unroll
        for (int ai = 0; ai < 2; ++ai)
#pragma unroll
            for (int m = 0; m < 4; ++m) { const int row = row0 + ai * HALF + m * 16; bf16_t* rowp = O + (size_t)row * ldc + col0;
                f32x4 o[2][2];
                if (kind == 0) { const int pos = row & 2047;
#pragma unroll
                    for (int n = 0; n < 2; ++n) { const f32x4 c4 = *(const f32x4*)(cosT + pos * 128 + j0 + 4 * n), s4 = *(const f32x4*)(sinT + pos * 128 + j0 + 4 * n);
                        const f32x4 x1 = acc[ai][0][m][n], x2 = acc[ai][1][m][n];
                        o[0][n] = (x1 * c4 - x2 * s4) * ksc; o[1][n] = (x1 * s4 + x2 * c4) * ksc; }
                } else if (kind == 1) {
#pragma unroll
                    for (int bj = 0; bj < 2; ++bj)
#pragma unroll
                        for (int n = 0; n < 2; ++n) o[bj][n] = acc[ai][bj][m][n];
                } else {
#pragma unroll
                    for (int bj = 0; bj < 2; ++bj)
#pragma unroll
                        for (int n = 0; n < 2; ++n) { const f32x4 v = acc[ai][bj][m][n]; f32x4 r;
#pragma unroll
                            for (int e = 0; e < 4; ++e) r[e] = v[e] * __builtin_amdgcn_rcpf(1.0f + __expf(-v[e]));
                            o[bj][n] = r; }
                }
#pragma unroll
                for (int bj = 0; bj < 2; ++bj) { u32x4 w; w.x = cvt_pk_bf16(o[bj][0][0], o[bj][0][1]); w.y = cvt_pk_bf16(o[bj][0][2], o[bj][0][3]); w.z = cvt_pk_bf16(o[bj][1][0], o[bj][1][1]); w.w = cvt_pk_bf16(o[bj][1][2], o[bj][1][3]);
                    *(u32x4*)(rowp + bj * HALF) = w; } }
    }
};

template <class Epi, class Sched, bool ALIGN_EPI = false, bool SP2 = false>
__device__ __forceinline__ void gemm_phase(PG8_LAS unsigned char* lds, const Gemm g, const Sched& S, const Epi& E) {
    int tid_l = threadIdx.x; asm volatile("" : "+v"(tid_l)); const int tid = tid_l, wid = __builtin_amdgcn_readfirstlane(tid >> 6), lane = tid & 63, wr = wid >> 2, wc = wid & 3, fr = lane & 15, fq = lane >> 4;
    const int K = g.K, nt = K / BK;
    unsigned voffA[2], voffB[2];
#pragma unroll
    for (int i = 0; i < 2; ++i) { int R, C; stage_rc(tid * 16 + i * 8192, R, C); const int Rb = Epi::PERM ? ((R & ~31) + perm32(R & 31)) : R;
        voffA[i] = (unsigned)(R * g.lda + C) * 2u; voffB[i] = (unsigned)(Rb * K + C) * 2u; }
    const size_t kstep = (size_t)(BK * 2);
    const size_t hsB = (size_t)HALF * K * 2, hsA = (size_t)HALF * g.lda * 2;
    const size_t tsA = 2 * hsA, tsB = 2 * hsB;
    const unsigned ldsw = (unsigned)wid * 1024u;
    const int aoff = lds_byte(wr * 64 + fr, fq * 8), boff = lds_byte(wc * 32 + fr, fq * 8);
#define PG8_SA(b, h) (((b) * 2 + (h)) * HTB)
#define PG8_SB(b, h) ((4 + (b) * 2 + (h)) * HTB)
#define PG8_STAGE(bufoff, gbase, voff) do { _Pragma("unroll") for (int _i = 0; _i < 2; ++_i) \
        __builtin_amdgcn_global_load_lds((const unsigned*)((const char*)(gbase) + (voff)[_i]), (PG8_LAS unsigned*)(lds + (bufoff) + ldsw + _i * 8192), 16, 0, 0); } while (0)
#define PG8_LDA(dst, b, h) do { _Pragma("unroll") for (int m = 0; m < 4; ++m) _Pragma("unroll") for (int k = 0; k < 2; ++k) dst[m][k] = *(const PG8_LAS bf16x8*)(lds + PG8_SA(b, h) + aoff + m * 2048 + k * 1024); } while (0)
#define PG8_LDB(dst, b, h) do { _Pragma("unroll") for (int n = 0; n < 2; ++n) _Pragma("unroll") for (int k = 0; k < 2; ++k) dst[n][k] = *(const PG8_LAS bf16x8*)(lds + PG8_SB(b, h) + boff + n * 2048 + k * 1024); } while (0)
#define PG8_MMA(ai, bj, At, Bt) do { __builtin_amdgcn_s_setprio(1); _Pragma("unroll") for (int m = 0; m < 4; ++m) _Pragma("unroll") for (int n = 0; n < 2; ++n) _Pragma("unroll") for (int k = 0; k < 2; ++k) \
        acc[ai][bj][m][n] = __builtin_amdgcn_mfma_f32_16x16x32_bf16(Bt[n][k], At[m][k], acc[ai][bj][m][n], 0, 0, 0); __builtin_amdgcn_s_setprio(0); } while (0)
#define PG8_WAIT_V(n) asm volatile("s_waitcnt vmcnt(" #n ")" ::: "memory")
#define PG8_WAIT_L(n) asm volatile("s_waitcnt lgkmcnt(" #n ")" ::: "memory")
#define PG8_BAR __builtin_amdgcn_s_barrier()
#define PG8_SCHED __builtin_amdgcn_sched_barrier(0)
    Unit cur, nxt; int ui = 0;
    if (!S.next(0, cur)) return;
    f32x4 acc[2][2][4][2];
#pragma unroll
    for (int a = 0; a < 2; ++a)
#pragma unroll
        for (int b = 0; b < 2; ++b)
#pragma unroll
            for (int m = 0; m < 4; ++m)
#pragma unroll
                for (int n = 0; n < 2; ++n) acc[a][b][m][n] = (f32x4){0.f, 0.f, 0.f, 0.f};
    bf16x8 At[4][2], B0[2][2], B1[2][2];
    const char* cA = (const char*)g.A + (size_t)cur.pm * tsA; const char* cB = (const char*)g.Bt + (size_t)cur.pn * tsB;
    S.a_ready(cur);
    if constexpr (SP2) {
        PG8_STAGE(PG8_SB(0, 0), cB, voffB); PG8_STAGE(PG8_SB(0, 1), cB + hsB, voffB); PG8_STAGE(PG8_SA(0, 0), cA, voffA); PG8_STAGE(PG8_SA(0, 1), cA + hsA, voffA);
        if (wr == 1) PG8_BAR;
        PG8_WAIT_V(2); PG8_BAR;
        PG8_STAGE(PG8_SB(1, 0), cB + kstep, voffB); PG8_STAGE(PG8_SA(1, 0), cA + kstep, voffA); PG8_STAGE(PG8_SB(1, 1), cB + hsB + kstep, voffB);
        PG8_WAIT_V(6); PG8_BAR;
    } else {
        PG8_STAGE(PG8_SB(0, 0), cB, voffB); PG8_STAGE(PG8_SA(0, 0), cA, voffA); PG8_STAGE(PG8_SB(0, 1), cB + hsB, voffB); PG8_STAGE(PG8_SA(0, 1), cA + hsA, voffA);
        if (wr == 1) PG8_BAR;
        PG8_WAIT_V(4); PG8_BAR;
        PG8_STAGE(PG8_SB(1, 0), cB + kstep, voffB); PG8_STAGE(PG8_SA(1, 0), cA + kstep, voffA); PG8_STAGE(PG8_SB(1, 1), cB + hsB + kstep, voffB);
        PG8_WAIT_V(6); PG8_BAR;
    }
    for (;;) {
        const bool has_next = S.next(ui + 1, nxt);
        const char* nA = has_next ? (const char*)g.A + (size_t)nxt.pm * tsA : cA; const char* nB = has_next ? (const char*)g.Bt + (size_t)nxt.pn * tsB : cB;
        for (int t = 0; t < nt; t += 2) {
            const bool last = (t == nt - 2);
            const char* a1 = cA + (size_t)(t + 1) * kstep;
            const char* a2 = last ? nA : cA + (size_t)(t + 2) * kstep; const char* b2 = last ? nB : cB + (size_t)(t + 2) * kstep;
            const char* a3 = a2 + kstep; const char* b3 = b2 + kstep;
            if (last && has_next) S.a_ready(nxt);
            if constexpr (SP2) {
            PG8_LDB(B0, 0, 0); PG8_LDB(B1, 0, 1); PG8_SCHED; PG8_LDA(At, 0, 0); PG8_STAGE(PG8_SA(1, 1), a1 + hsA, voffA);
            PG8_WAIT_V(8); PG8_WAIT_L(0); PG8_BAR; PG8_MMA(0, 0, At, B0); PG8_MMA(0, 1, At, B1); PG8_BAR; PG8_SCHED;
            PG8_LDA(At, 0, 1); PG8_STAGE(PG8_SB(0, 0), b2, voffB); PG8_STAGE(PG8_SB(0, 1), b2 + hsB, voffB); PG8_STAGE(PG8_SA(0, 0), a2, voffA);
            PG8_WAIT_V(8); PG8_WAIT_L(0); PG8_BAR; PG8_MMA(1, 0, At, B0); PG8_MMA(1, 1, At, B1); PG8_BAR; PG8_SCHED;
            PG8_LDB(B0, 1, 0); PG8_LDB(B1, 1, 1); PG8_SCHED; PG8_LDA(At, 1, 0); PG8_STAGE(PG8_SA(0, 1), a2 + hsA, voffA);
            PG8_WAIT_V(8); PG8_WAIT_L(0); PG8_BAR; PG8_MMA(0, 0, At, B0); PG8_MMA(0, 1, At, B1); PG8_BAR; PG8_SCHED;
            PG8_LDA(At, 1, 1); PG8_STAGE(PG8_SB(1, 0), b3, voffB); PG8_STAGE(PG8_SB(1, 1), b3 + hsB, voffB); PG8_STAGE(PG8_SA(1, 0), a3, voffA);
            PG8_WAIT_V(8); PG8_WAIT_L(0); PG8_BAR; PG8_MMA(1, 0, At, B0); PG8_MMA(1, 1, At, B1); PG8_BAR; PG8_SCHED;
            } else {
            PG8_LDB(B0, 0, 0); PG8_SCHED; PG8_LDA(At, 0, 0); PG8_STAGE(PG8_SA(1, 1), a1 + hsA, voffA);
            PG8_WAIT_L(8); PG8_BAR; PG8_WAIT_L(0); PG8_MMA(0, 0, At, B0); PG8_BAR; PG8_SCHED;
            PG8_LDB(B1, 0, 1); PG8_STAGE(PG8_SB(0, 0), b2, voffB);
            PG8_BAR; PG8_WAIT_L(0); PG8_MMA(0, 1, At, B1); PG8_BAR;
            PG8_LDA(At, 0, 1); PG8_STAGE(PG8_SA(0, 0), a2, voffA);
            PG8_BAR; PG8_WAIT_L(0); PG8_MMA(1, 0, At, B0); PG8_BAR; PG8_SCHED;
            PG8_STAGE(PG8_SB(0, 1), b2 + hsB, voffB);
            PG8_WAIT_V(6); PG8_BAR; PG8_MMA(1, 1, At, B1); PG8_BAR;
            PG8_LDB(B0, 1, 0); PG8_SCHED; PG8_LDA(At, 1, 0); PG8_STAGE(PG8_SA(0, 1), a2 + hsA, voffA);
            PG8_WAIT_L(8); PG8_BAR; PG8_WAIT_L(0); PG8_MMA(0, 0, At, B0); PG8_BAR; PG8_SCHED;
            PG8_LDB(B1, 1, 1); PG8_STAGE(PG8_SB(1, 0), b3, voffB);
            PG8_BAR; PG8_WAIT_L(0); PG8_MMA(0, 1, At, B1); PG8_BAR;
            PG8_LDA(At, 1, 1); PG8_STAGE(PG8_SA(1, 0), a3, voffA);
            PG8_BAR; PG8_WAIT_L(0); PG8_MMA(1, 0, At, B0); PG8_BAR; PG8_SCHED;
            PG8_STAGE(PG8_SB(1, 1), b3 + hsB, voffB);
            PG8_WAIT_V(6); PG8_BAR; PG8_MMA(1, 1, At, B1); PG8_BAR;
            }
        }
        if constexpr (ALIGN_EPI) { if (wr == 0) PG8_BAR; }
        if constexpr (!Epi::AFTER_DRAIN) { E(acc, cur, wr, wc, fr, fq); S.done(cur); }
        if (!has_next) break;
#pragma unroll
        for (int a = 0; a < 2; ++a)
#pragma unroll
            for (int b = 0; b < 2; ++b)
#pragma unroll
                for (int m = 0; m < 4; ++m)
#pragma unroll
                    for (int n = 0; n < 2; ++n) acc[a][b][m][n] = (f32x4){0.f, 0.f, 0.f, 0.f};
        cur = nxt; cA = nA; cB = nB; ++ui;
        if constexpr (ALIGN_EPI) { if (wr == 1) PG8_BAR; }
    }
    PG8_WAIT_V(0);
    if constexpr (!ALIGN_EPI) { if (wr == 0) PG8_BAR; }
    PG8_BAR;
    if constexpr (Epi::AFTER_DRAIN) { E.fused(acc, cur, wr, wc, fr, fq, lds, wid, lane); S.done(cur); }
#undef PG8_SA
#undef PG8_SB
#undef PG8_STAGE
#undef PG8_LDA
#undef PG8_LDB
#undef PG8_MMA
#undef PG8_WAIT_V
#undef PG8_WAIT_L
#undef PG8_BAR
#undef PG8_SCHED
}
}
namespace attn_body {
using bf16=__hip_bfloat16;
using bf16x8=__attribute__((ext_vector_type(8)))short;
using s16x4=__attribute__((ext_vector_type(4)))short;
using f32x16=__attribute__((ext_vector_type(16)))float;
using u32x4=__attribute__((ext_vector_type(4)))unsigned;
constexpr int BATCH=8,NHEAD=16,SEQ=2048,D=64,DM=1024;
constexpr int NW=8,QBLK=32,QB=QBLK*NW,KVBLK=64,NQB=SEQ/QB;
constexpr int ATTN_PITCH=DM, ATTN_UNIT_ROWS=QB;
__device__ __forceinline__ int crow(int r,int hi){return (r&3)+8*(r>>2)+4*hi;}
#define SBAR() __builtin_amdgcn_sched_barrier(0)
__device__ __forceinline__ void cmask(f32x16&p0,f32x16&p1,int jb,int qrel,int hi){
  const float NEG=-INFINITY; int kb=64*jb+4*hi;
  #pragma unroll
  for(int r=0;r<16;++r){int kv=kb+(r&3)+8*(r>>2); if(kv>qrel)p0[r]=NEG; if(kv+32>qrel)p1[r]=NEG;}
}

constexpr int NSLOT=3, SLOTB=8192;
constexpr int LDS_K=0, LDS_V=NSLOT*SLOTB, LDS_WS=2*NSLOT*SLOTB, LDS_OST=LDS_WS+NW*64*4, LDS_BYTES=LDS_OST+NW*4096;
constexpr float C2=0.125f*1.4426950408889634f;
__device__ __forceinline__ void glds16(const void*gsrc,unsigned lds_dst){unsigned keep;
  asm volatile("s_mov_b32 %0, m0\n\ts_mov_b32 m0, %2\n\ts_nop 0\n\tglobal_load_lds_dwordx4 %1, off\n\ts_mov_b32 m0, %0":"=&s"(keep):"v"(gsrc),"s"(lds_dst):"memory");}
__device__ __forceinline__ float max3f(float a,float b,float c){float r;asm("v_max3_f32 %0, %1, %2, %3":"=v"(r):"v"(a),"v"(b),"v"(c));return r;}
__device__ __forceinline__ float max2f(float a,float b){float r;asm("v_max_f32_e32 %0, %1, %2":"=v"(r):"v"(a),"v"(b));return r;}
__device__ __forceinline__ float fadd_s(float a,float b){float r;asm("v_add_f32_e32 %0, %1, %2":"=v"(r):"v"(a),"v"(b));return r;}
__device__ __forceinline__ float fsub_s(float a,float b){float r;asm("v_sub_f32_e32 %0, %1, %2":"=v"(r):"v"(a),"v"(b));return r;}
typedef float f32x2_t __attribute__((ext_vector_type(2))); typedef __bf16 bf16x2_t __attribute__((ext_vector_type(2)));
__device__ __forceinline__ unsigned cvtpk_s(float lo,float hi){f32x2_t v={lo,hi};bf16x2_t b=__builtin_convertvector(v,bf16x2_t);return __builtin_bit_cast(unsigned,b);}
#define WAIT_BAR(N) asm volatile("s_waitcnt vmcnt(" #N ") lgkmcnt(0)\n\ts_barrier":::"memory")

__device__ __forceinline__ void qkt(f32x16&p0,f32x16&p1,const char*Kslot,const bf16x8*qr,const f32x16&negm,int r32,int hi){
  const char*kb=Kslot+hi*1024+r32*16;
  #pragma unroll
  for(int d0=0;d0<4;++d0){
    const bf16x8 b0=*reinterpret_cast<const bf16x8*>(kb+d0*2048);
    const bf16x8 b1=*reinterpret_cast<const bf16x8*>(kb+d0*2048+512);
    if(d0==0){p0=__builtin_amdgcn_mfma_f32_32x32x16_bf16(b0,qr[0],negm,0,0,0);p1=__builtin_amdgcn_mfma_f32_32x32x16_bf16(b1,qr[0],negm,0,0,0);}
    else{p0=__builtin_amdgcn_mfma_f32_32x32x16_bf16(b0,qr[d0],p0,0,0,0);p1=__builtin_amdgcn_mfma_f32_32x32x16_bf16(b1,qr[d0],p1,0,0,0);}}
}
typedef __attribute__((address_space(3))) const char* lds_cptr;
typedef short v4i16_t __attribute__((ext_vector_type(4)));
__device__ __forceinline__ void kload8(bf16x8*kf,lds_cptr kp){
  kf[0]=*(const __attribute__((address_space(3))) bf16x8*)(kp);      kf[1]=*(const __attribute__((address_space(3))) bf16x8*)(kp+512);
  kf[2]=*(const __attribute__((address_space(3))) bf16x8*)(kp+2048); kf[3]=*(const __attribute__((address_space(3))) bf16x8*)(kp+2560);
  kf[4]=*(const __attribute__((address_space(3))) bf16x8*)(kp+4096); kf[5]=*(const __attribute__((address_space(3))) bf16x8*)(kp+4608);
  kf[6]=*(const __attribute__((address_space(3))) bf16x8*)(kp+6144); kf[7]=*(const __attribute__((address_space(3))) bf16x8*)(kp+6656);
}
__device__ __forceinline__ void kload2(bf16x8*kf,lds_cptr kp,int j){ kf[2*j]=*(const __attribute__((address_space(3))) bf16x8*)(kp+j*2048); kf[2*j+1]=*(const __attribute__((address_space(3))) bf16x8*)(kp+j*2048+512); }
__device__ __forceinline__ s16x4 vtr(lds_cptr p){ return __builtin_bit_cast(s16x4,__builtin_amdgcn_ds_read_tr16_b64_v4i16((__attribute__((address_space(3))) v4i16_t*)p)); }
__device__ __forceinline__ float rowmax(const f32x16&p0,const f32x16&p1){
  float a=max3f(p0[0],p0[1],p1[0]),b=max3f(p0[2],p0[3],p1[1]);a=max3f(a,p1[2],p1[3]);
  #pragma unroll
  for(int r=4;r<16;r+=4){a=max3f(a,p0[r],p0[r+1]);b=max3f(b,p0[r+2],p0[r+3]);a=max3f(a,p1[r],p1[r+1]);b=max3f(b,p1[r+2],p1[r+3]);}
  const float m=max2f(a,b);
  auto rr=__builtin_amdgcn_permlane32_swap(__float_as_uint(m),__float_as_uint(m),false,false);
  return max2f(__uint_as_float(rr[0]),__uint_as_float(rr[1]));
}
__device__ __forceinline__ void pv(f32x16*o,int vb,bf16x8 pa0,bf16x8 pa1,bf16x8 pa2,bf16x8 pa3){
  #pragma unroll
  for(int d0=0;d0<2;++d0){s16x4 lo[4],hi[4];
    #pragma unroll
    for(int ks=0;ks<4;++ks){
      asm volatile("ds_read_b64_tr_b16 %0,%1 offset:%c2":"=&v"(lo[ks]):"v"(vb),"i"(d0*4096+ks*1024):"memory");
      asm volatile("ds_read_b64_tr_b16 %0,%1 offset:%c2":"=&v"(hi[ks]):"v"(vb),"i"(d0*4096+ks*1024+512):"memory");}
    asm volatile("s_waitcnt lgkmcnt(0)":::"memory");SBAR();
    #define PK(k) (bf16x8){lo[k][0],lo[k][1],lo[k][2],lo[k][3],hi[k][0],hi[k][1],hi[k][2],hi[k][3]}
    o[d0]=__builtin_amdgcn_mfma_f32_32x32x16_bf16(pa0,PK(0),o[d0],0,0,0);
    o[d0]=__builtin_amdgcn_mfma_f32_32x32x16_bf16(pa1,PK(1),o[d0],0,0,0);
    o[d0]=__builtin_amdgcn_mfma_f32_32x32x16_bf16(pa2,PK(2),o[d0],0,0,0);
    o[d0]=__builtin_amdgcn_mfma_f32_32x32x16_bf16(pa3,PK(3),o[d0],0,0,0);
    #undef PK
  }
}

#ifndef ATTN_STORE16
#define ATTN_STORE16(p,v) (*(u32x4*)(p)=(v))
#endif
template<int THRL> __device__ __forceinline__ void attn_unit(int b,int qkcol,int vcol,int qb,const bf16*Q,const bf16*__restrict__ K,const bf16*__restrict__ V,bf16*O,char*shm){
  const int tid=threadIdx.x,lane=tid&63,r32=lane&31,hi=lane>>5; const int wid=__builtin_amdgcn_readfirstlane(tid>>6);
  const long rowbase=(long)b*SEQ; const int q0=qb*QB;
  const bf16*Qw=Q+(rowbase+q0+wid*QBLK)*DM+qkcol;
  const bf16*Kh=K+rowbase*DM+qkcol,*Vh=V+rowbase*DM+vcol;
  const unsigned lds0=(unsigned)(uintptr_t)shm;
  float*wsf=(float*)(shm+LDS_WS)+wid*64;
  const bf16*ksrc=Kh+(long)lane*DM+wid*8;
  const bf16*vsrc=Vh+(long)(16*(wid&3)+(lane>>2))*DM+(wid>>2)*32+(lane&3)*8;
  const unsigned kdst=lds0+LDS_K+wid*1024, vdst=lds0+LDS_V+wid*1024;
  #define DMA_K(t,slot) glds16(ksrc+(long)(t)*KVBLK*DM,(unsigned)__builtin_amdgcn_readfirstlane(kdst+(slot)))
  #define DMA_V(t,slot) glds16(vsrc+(long)(t)*KVBLK*DM,(unsigned)__builtin_amdgcn_readfirstlane(vdst+(slot)))
  const int vb0=(int)(lds0+LDS_V)+((lane>>4)&1)*32+(lane&3)*8+(4*hi+((lane&15)>>2))*64;
  const char*Kbase=shm+LDS_K; bf16x8 kf[8];
  const lds_cptr shm3=(lds_cptr)shm; const lds_cptr kp0=shm3+LDS_K+hi*1024+r32*16; const lds_cptr vp0=shm3+LDS_V+((lane>>4)&1)*32+(lane&3)*8+(4*hi+((lane&15)>>2))*64;
  const int NT=(q0+QB)/KVBLK;
  DMA_K(0,0);DMA_V(0,0);DMA_K(1,SLOTB);
  bf16x8 qr[4];
  #pragma unroll
  for(int d0=0;d0<4;++d0)qr[d0]=*reinterpret_cast<const bf16x8*>(&Qw[(long)r32*DM+d0*16+hi*8]);
  float mhat=0.f,l_reg=0.f;f32x16 o[2];o[0]=f32x16{};o[1]=f32x16{};f32x16 negm=f32x16{};asm volatile("":"+v"(negm));
  const int qrel=wid*QBLK+r32;
  #define CMASK(P0,P1,t) do{int jb_=(t)-(NT-4); if(jb_>=0)cmask(P0,P1,jb_,qrel,hi);}while(0)
  bool resc=false;
  #define START(P0,P1) do{ const float rm=rowmax(P0,P1); resc=false; \
    { const float dl=rm; mhat=fadd_s(mhat,dl); \
      _Pragma("unroll") for(int r=0;r<16;++r){P0[r]=fsub_s(P0[r],dl);P1[r]=fsub_s(P1[r],dl);} \
      _Pragma("unroll") for(int r=0;r<16;++r)negm[r]=-mhat; asm volatile("":"+v"(negm)); } \
    _Pragma("unroll") for(int r=0;r<16;++r)P0[r]=__builtin_amdgcn_exp2f(P0[r]); }while(0)
  #define RESC() do{ if(resc){ asm volatile("s_waitcnt lgkmcnt(0)":::"memory"); \
      _Pragma("unroll") for(int d_=0;d_<2;++d_) _Pragma("unroll") for(int r=0;r<16;++r)o[d_][r]*=wsf[crow(r,hi)]; } }while(0)
  f32x16 pA0,pA1,pB0,pB1;
  int sl_prev=0,sl_cur=0,sl_next=SLOTB;
  #define ROT() do{sl_prev=sl_cur;sl_cur=sl_next;sl_next=(sl_next==(NSLOT-1)*SLOTB)?0:sl_next+SLOTB;}while(0)
  DMA_K(2,2*SLOTB);
  WAIT_BAR(3);
  qkt(pA0,pA1,Kbase,qr,negm,r32,hi);asm volatile("s_nop 15\n\ts_nop 7":"+v"(pA0),"+v"(pA1));CMASK(pA0,pA1,0);
  START(pA0,pA1);
  _Pragma("unroll") for(int r=0;r<16;++r)pA1[r]=__builtin_amdgcn_exp2f(pA1[r]);
  WAIT_BAR(0);
  DMA_K(3,0);DMA_V(1,SLOTB);
  ROT();
  kload8(kf,kp0+sl_cur);
  WAIT_BAR(2);
  s16x4 vlo[8],vhi[8]; u32x4 pw0,pw1,pw2,pw3;
  #define PKW(P,B) cvtpk_s(P[B],P[B+1])
  #define PAF(k) __builtin_bit_cast(bf16x8,pw##k)
  #define VFR(i) (bf16x8){vlo[i][0],vlo[i][1],vlo[i][2],vlo[i][3],vhi[i][0],vhi[i][1],vhi[i][2],vhi[i][3]}
  #define PIN(x) asm volatile("":"+v"(x))
  #define MX3(a,b,c) __builtin_fmaxf(__builtin_fmaxf((a),(b)),(c))
  #define GAPA(MF,A0,A1,A2,A3,W0,W1,PW) do{ MF; sacc+=A0; sacc+=A1; sacc+=A2; sacc+=A3; PIN(sacc); W0; W1; PIN(PW); SBAR(); }while(0)
  #define EX(v) __builtin_amdgcn_exp2f(v)
  #define GAPB(MF,X,B) do{ MF; X[B]=EX(X[B]); X[B+1]=EX(X[B+1]); X[B+2]=EX(X[B+2]); X[B+3]=EX(X[B+3]); PIN(X); SBAR(); }while(0)
  #define VRD(i) do{ vlo[i]=vtr(vp_+(((i)>>2)*4096+((i)&3)*1024)); vhi[i]=vtr(vp_+(((i)>>2)*4096+((i)&3)*1024+512)); }while(0)
  #define KRD(G,j) do{ if(G){ kload2(kf,kp0+sl_next,j); SBAR(); } }while(0)
  #define STEP(C0,C1,P0,P1,t,GK,GV,GL) do{ SBAR(); \
    const lds_cptr vp_=vp0+sl_prev; \
    VRD(0); SBAR(); float sacc=(P0[0]+P0[1]); \
    GAPA(C0=__builtin_amdgcn_mfma_f32_32x32x16_bf16(kf[0],qr[0],negm,0,0,0), P0[2],P0[3],P0[4],P0[5],     pw0[0]=PKW(P0,0), pw0[1]=PKW(P0,2), pw0); \
    VRD(4); SBAR(); GAPA(C1=__builtin_amdgcn_mfma_f32_32x32x16_bf16(kf[1],qr[0],negm,0,0,0), P0[6],P0[7],P0[8],P0[9],     pw0[2]=PKW(P0,4), pw0[3]=PKW(P0,6), pw0); \
    VRD(1); SBAR(); GAPA(C0=__builtin_amdgcn_mfma_f32_32x32x16_bf16(kf[2],qr[1],C0,0,0,0),   P0[10],P0[11],P0[12],P0[13], pw1[0]=PKW(P0,8), pw1[1]=PKW(P0,10), pw1); \
    VRD(5); SBAR(); GAPA(C1=__builtin_amdgcn_mfma_f32_32x32x16_bf16(kf[3],qr[1],C1,0,0,0),   P0[14],P0[15],P1[0],P1[1],   pw1[2]=PKW(P0,12),pw1[3]=PKW(P0,14), pw1); \
    VRD(2); SBAR(); GAPA(C0=__builtin_amdgcn_mfma_f32_32x32x16_bf16(kf[4],qr[2],C0,0,0,0),   P1[2],P1[3],P1[4],P1[5],     pw2[0]=PKW(P1,0), pw2[1]=PKW(P1,2), pw2); \
    VRD(6); SBAR(); GAPA(C1=__builtin_amdgcn_mfma_f32_32x32x16_bf16(kf[5],qr[2],C1,0,0,0),   P1[6],P1[7],P1[8],P1[9],     pw2[2]=PKW(P1,4), pw2[3]=PKW(P1,6), pw2); \
    VRD(3); SBAR(); GAPA(C0=__builtin_amdgcn_mfma_f32_32x32x16_bf16(kf[6],qr[3],C0,0,0,0),   P1[10],P1[11],P1[12],P1[13], pw3[0]=PKW(P1,8), pw3[1]=PKW(P1,10), pw3); \
    VRD(7); SBAR(); GAPA(C1=__builtin_amdgcn_mfma_f32_32x32x16_bf16(kf[7],qr[3],C1,0,0,0),   P1[14],P1[15],0.f,0.f,       pw3[2]=PKW(P1,12),pw3[3]=PKW(P1,14), pw3); \
    l_reg+=sacc; \
    if(GK){DMA_K((t)+3,sl_cur);} if(GV){DMA_V((t)+1,sl_next);} \
    CMASK(C0,C1,t); \
    { float a=MX3(C0[0],C0[1],C1[0]),b=MX3(C0[2],C0[3],C1[1]); a=MX3(a,C1[2],C1[3]); \
      _Pragma("unroll") for(int r=4;r<16;r+=4){a=MX3(a,C0[r],C0[r+1]);b=MX3(b,C0[r+2],C0[r+3]);a=MX3(a,C1[r],C1[r+1]);b=MX3(b,C1[r+2],C1[r+3]);} \
      float rm=__builtin_fmaxf(a,b); { auto rr=__builtin_amdgcn_permlane32_swap(__float_as_uint(rm),__float_as_uint(rm),false,false); rm=__builtin_fmaxf(__uint_as_float(rr[0]),__uint_as_float(rr[1])); } \
      resc=false; \
      if(__builtin_expect(__any(rm>(float)THRL),0)){ const float dl=__builtin_fmaxf(rm,0.f); mhat+=dl; \
        _Pragma("unroll") for(int r=0;r<16;++r){C0[r]-=dl;C1[r]-=dl;} \
        _Pragma("unroll") for(int r=0;r<16;++r)negm[r]=-mhat; asm volatile("":"+v"(negm)); \
        const float f=__builtin_amdgcn_exp2f(-dl); l_reg*=f; if(hi==0)wsf[r32]=f; resc=true; } } \
    SBAR(); \
    GAPB(o[0]=__builtin_amdgcn_mfma_f32_32x32x16_bf16(PAF(0),VFR(0),o[0],0,0,0), C0,0); \
    GAPB(o[1]=__builtin_amdgcn_mfma_f32_32x32x16_bf16(PAF(0),VFR(4),o[1],0,0,0), C0,4); \
    KRD(GL,0); GAPB(o[0]=__builtin_amdgcn_mfma_f32_32x32x16_bf16(PAF(1),VFR(1),o[0],0,0,0), C0,8); \
    KRD(GL,1); GAPB(o[1]=__builtin_amdgcn_mfma_f32_32x32x16_bf16(PAF(1),VFR(5),o[1],0,0,0), C0,12); \
    KRD(GL,2); GAPB(o[0]=__builtin_amdgcn_mfma_f32_32x32x16_bf16(PAF(2),VFR(2),o[0],0,0,0), C1,0); \
    KRD(GL,3); GAPB(o[1]=__builtin_amdgcn_mfma_f32_32x32x16_bf16(PAF(2),VFR(6),o[1],0,0,0), C1,4); \
    GAPB(o[0]=__builtin_amdgcn_mfma_f32_32x32x16_bf16(PAF(3),VFR(3),o[0],0,0,0), C1,8); \
    GAPB(o[1]=__builtin_amdgcn_mfma_f32_32x32x16_bf16(PAF(3),VFR(7),o[1],0,0,0), C1,12); \
    }while(0)
  int t=1;
  #undef CMASK
  #define CMASK(P0,P1,t) do{}while(0)
  for(;t+5<NT;t+=2){
    STEP(pB0,pB1,pA0,pA1,t,true,true,true);     WAIT_BAR(2); RESC(); ROT();
    STEP(pA0,pA1,pB0,pB1,t+1,true,true,true);   WAIT_BAR(2); RESC(); ROT();
  }
  #undef CMASK
  #define CMASK(P0,P1,t) do{int jb_=(t)-(NT-4); if(jb_>=0)cmask(P0,P1,jb_,qrel,hi);}while(0)
  #define ENDW(tt) do{ if((tt)+3<NT){WAIT_BAR(2);} else if((tt)+2<NT){WAIT_BAR(1);} else {WAIT_BAR(0);} }while(0)
  for(;t+1<NT;t+=2){
    STEP(pB0,pB1,pA0,pA1,t,(t+3<NT),(t+1<NT),(t+1<NT));       ENDW(t);   RESC(); ROT();
    STEP(pA0,pA1,pB0,pB1,t+1,(t+4<NT),(t+2<NT),(t+2<NT));     ENDW(t+1); RESC(); ROT();
  }
  STEP(pB0,pB1,pA0,pA1,NT-1,false,false,false); RESC();
  { float sacc=pB0[0]+pB0[1]; _Pragma("unroll") for(int r=2;r<16;++r)sacc+=pB0[r]; _Pragma("unroll") for(int r=0;r<16;++r)sacc+=pB1[r]; l_reg+=sacc;
    pw0=(u32x4){PKW(pB0,0),PKW(pB0,2),PKW(pB0,4),PKW(pB0,6)};pw1=(u32x4){PKW(pB0,8),PKW(pB0,10),PKW(pB0,12),PKW(pB0,14)};pw2=(u32x4){PKW(pB1,0),PKW(pB1,2),PKW(pB1,4),PKW(pB1,6)};pw3=(u32x4){PKW(pB1,8),PKW(pB1,10),PKW(pB1,12),PKW(pB1,14)};
    SBAR(); pv(o,vb0+sl_cur,PAF(0),PAF(1),PAF(2),PAF(3)); }
  #undef PKW
  #undef PAF
  #undef VFR
  #undef PIN
  #undef MX3
  #undef GAPA
  #undef GAPB
  #undef EX
  #undef VRD
  #undef KRD
  #undef STEP
  #undef ENDW
  {auto rr=__builtin_amdgcn_permlane32_swap(__float_as_uint(l_reg),__float_as_uint(l_reg),false,false);l_reg=__uint_as_float(rr[0])+__uint_as_float(rr[1]);}
  if(hi==0)wsf[32+r32]=l_reg;asm volatile("s_waitcnt lgkmcnt(0)":::"memory");
  float rli[16];
  #pragma unroll
  for(int r=0;r<16;++r)rli[r]=__builtin_amdgcn_rcpf(wsf[32+crow(r,hi)]);
  bf16*Ow=O+(rowbase+q0+wid*QBLK)*DM+vcol;
  { bf16*stg=(bf16*)(shm+LDS_OST)+wid*2048;
    #pragma unroll
    for(int r=0;r<16;++r){const int orow=crow(r,hi);
      #pragma unroll
      for(int d0=0;d0<2;++d0)stg[orow*64+d0*32+r32]=__float2bfloat16(o[d0][r]*rli[r]);}
    asm volatile("s_waitcnt lgkmcnt(0)":::"memory");
    #pragma unroll
    for(int i=0;i<4;++i){const int row=i*8+(lane>>3),ch=lane&7; const u32x4 v=*(const u32x4*)(stg+row*64+ch*8); ATTN_STORE16(Ow+(long)row*DM+ch*8,v);} }
  asm volatile("s_waitcnt lgkmcnt(0)\n\ts_barrier":::"memory");
  #undef DMA_K
  #undef DMA_V
  #undef CMASK
  #undef START
  #undef RESC
  #undef ROT
}
constexpr int ATTN_LDS_BYTES=LDS_BYTES;
struct AttnTensors { const bf16* Q; const bf16* K; const bf16* V; bf16* O0; bf16* O1; };
struct AttnUnit { int bh; int qb; };
struct StaticOrder {
  int vcu;
  __device__ __forceinline__ explicit StaticOrder(int grid,int block):vcu((block%8)*(grid/8)+block/8){}
  __device__ __forceinline__ bool next(int i,AttnUnit&u)const{ if(i>=8)return false; const int s=vcu&7; u.bh=vcu; u.qb=(i+s)&7; return true; }
  __device__ __forceinline__ void a_ready(const AttnUnit&)const{}
  __device__ __forceinline__ void done(const AttnUnit&)const{}
};
template<class Sched,int THRL=8> __device__ __forceinline__ void attn_phase(char*lds,const AttnTensors&T,const Sched&S){
  AttnUnit u;
  for(int i=0;S.next(i,u);++i){ S.a_ready(u); { const int vh=u.bh&31,hh=vh>>2,cc=(vh>>1)&1,hf=vh&1; attn_unit<THRL>(u.bh>>5,(hh*2+cc)*64,hh*128+hf*64,u.qb,T.Q,T.K,T.V,cc?T.O1:T.O0,lds); } S.done(u); }
}
#undef SBAR
#undef WAIT_BAR
}

constexpr int NWAVES = 8;
constexpr int N_LAUNCHES = MK_N_LAUNCHES;
constexpr int NPHASE = 19;
constexpr int M = 16384, SEQ = 2048, D = 1024, NPROJ = 6144, RV = 2048, FF = 2816, FF2 = 5632;
constexpr float EPS = 1e-6f;
constexpr size_t MiB = 1u << 20;
constexpr size_t WS_CTL = 0, CTL_ZERO_BYTES = 1 * MiB;
constexpr size_t WS_COS = 1 * MiB, WS_SIN = 2 * MiB;
constexpr size_t WS_WA = 4 * MiB;
constexpr size_t WS_WB = 16 * MiB;
constexpr size_t WS_WC = 20 * MiB;
constexpr size_t WS_WD = 31 * MiB;
constexpr size_t WS_BIG = 37 * MiB;
constexpr size_t B_PROJ = WS_BIG;
constexpr size_t B_H = WS_BIG;
constexpr size_t B_UP = WS_BIG;
constexpr size_t B_XN = WS_BIG + 176 * MiB;
constexpr size_t B_SIDE = WS_BIG + 208 * MiB;
constexpr size_t B_XN2 = WS_BIG;
constexpr size_t B_QKV = WS_BIG + 32 * MiB;
constexpr size_t B_O0 = WS_BIG + 128 * MiB, B_O1 = WS_BIG + 160 * MiB;
constexpr size_t B_ON = WS_BIG;
constexpr size_t B_H2 = WS_BIG + 32 * MiB;
constexpr size_t WS_END = 256 * MiB;
static_assert(B_SIDE + (size_t)256 * 2 * FF * 2 <= WS_END && B_PROJ + (size_t)M * NPROJ * 2 <= WS_END && B_O1 + (size_t)M * D * 2 <= WS_END, "d_ws map");
constexpr int RING_OFF = 0, RING_BYTES = 131072;
constexpr int LDS_BYTES = 147456;

#define GAS __attribute__((address_space(1)))
#define LAS __attribute__((address_space(3)))
#define DI __device__ __forceinline__
typedef unsigned short bf16;
typedef unsigned v4u __attribute__((ext_vector_type(4)));
typedef unsigned v2u __attribute__((ext_vector_type(2)));
typedef float f32x4 __attribute__((ext_vector_type(4)));
typedef short bf16x8 __attribute__((ext_vector_type(8)));
typedef short v4i16 __attribute__((ext_vector_type(4)));
typedef float f32x2v __attribute__((ext_vector_type(2)));
typedef __bf16 bf16x2v __attribute__((ext_vector_type(2)));
#define LDS_WAIT() asm volatile("s_waitcnt lgkmcnt(0)" ::: "memory")

DI unsigned pk2(float lo, float hi) { f32x2v v = {lo, hi}; bf16x2v b = __builtin_convertvector(v, bf16x2v); return __builtin_bit_cast(unsigned, b); }
DI float bflo(unsigned w) { return __uint_as_float(w << 16); }
DI float bfhi(unsigned w) { return __uint_as_float(w & 0xffff0000u); }
DI float wave_sum(float v) {
#pragma unroll
    for (int o = 1; o < 64; o <<= 1) v += __shfl_xor(v, o);
    return v;
}

constexpr int CONV_TILE = 64 * 65 * 4;
DI void transpose_item(const float* W, int K, int N, bf16* WT, int row_off, const float* gain, int kmod, float cs, LAS float* scr, int item, int lane) {
    const int nblk = N / 64, kb = item / nblk, nb = item % nblk, k0 = 64 * kb, n0 = 64 * nb;
    const int lr = lane >> 4, lc = (lane & 15) * 4;
    f32x4 v[16];
#pragma unroll
    for (int i = 0; i < 16; ++i) v[i] = *(const f32x4*)(W + (size_t)(k0 + 4 * i + lr) * N + n0 + lc);
#pragma unroll
    for (int i = 0; i < 16; ++i) { const int kk = 4 * i + lr; float g = cs; if (gain) g *= gain[(k0 + kk) % kmod];
        LAS float* s = scr + kk * 65 + lc; s[0] = v[i].x * g; s[1] = v[i].y * g; s[2] = v[i].z * g; s[3] = v[i].w * g; }
    LDS_WAIT(); asm volatile("" ::: "memory");
    const int c = lane & 7;
#pragma unroll
    for (int j = 0; j < 8; ++j) { const int n = (lane >> 3) + 8 * j; const LAS float* s = scr + (8 * c) * 65 + n;
        v4u o; o.x = pk2(s[0 * 65], s[1 * 65]); o.y = pk2(s[2 * 65], s[3 * 65]); o.z = pk2(s[4 * 65], s[5 * 65]); o.w = pk2(s[6 * 65], s[7 * 65]);
        *(v4u*)(WT + (size_t)(row_off + n0 + n) * K + k0 + 8 * c) = o; }
    LDS_WAIT(); asm volatile("" ::: "memory");
}
DI void convert_matrix(const float* W, int K, int N, bf16* WT, int row_off, const float* gain, int kmod, float cs, LAS unsigned char* lds, int gw, int NGW, int wave, int lane) {
    LAS float* scr = (LAS float*)(lds + wave * CONV_TILE);
    const int nitems = (K / 64) * (N / 64);
    for (int it = gw; it < nitems; it += NGW) transpose_item(W, K, N, WT, row_off, gain, kmod, cs, scr, it, lane);
}

DI void norm_rows(const float* x, bf16* xn, int gw, int NGW, int lane) {
    for (int m = 2 * gw; m < M; m += 2 * NGW) {
        f32x4 v[2][4]; float s[2] = {0.f, 0.f};
#pragma unroll
        for (int r = 0; r < 2; ++r) { const f32x4* xr = (const f32x4*)(x + (size_t)(m + r) * D) + lane;
#pragma unroll
            for (int j = 0; j < 4; ++j) v[r][j] = xr[64 * j]; }
#pragma unroll
        for (int r = 0; r < 2; ++r) {
#pragma unroll
            for (int j = 0; j < 4; ++j) s[r] += (v[r][j].x * v[r][j].x + v[r][j].y * v[r][j].y) + (v[r][j].z * v[r][j].z + v[r][j].w * v[r][j].w);
            const float rstd = 1.0f / sqrtf(wave_sum(s[r]) * (1.f / D) + EPS);
            v2u* o8 = (v2u*)(xn + (size_t)(m + r) * D) + lane;
#pragma unroll
            for (int j = 0; j < 4; ++j) { v2u w; w.x = pk2(v[r][j].x * rstd, v[r][j].y * rstd); w.y = pk2(v[r][j].z * rstd, v[r][j].w * rstd); o8[64 * j] = w; } }
    }
}
DI void resid_rows(const bf16* h, const float* base, const float* gain, float* xo, bf16* xn, int gw, int NGW, int lane) {
    f32x4 gv[4];
#pragma unroll
    for (int j = 0; j < 4; ++j) gv[j] = ((const f32x4*)gain)[lane + 64 * j];
    for (int m = 2 * gw; m < M; m += 2 * NGW) {
        v2u hw[2][4]; f32x4 bv[2][4];
#pragma unroll
        for (int r = 0; r < 2; ++r) { const v2u* hr = (const v2u*)(h + (size_t)(m + r) * D) + lane; const f32x4* br = (const f32x4*)(base + (size_t)(m + r) * D) + lane;
#pragma unroll
            for (int j = 0; j < 4; ++j) { hw[r][j] = hr[64 * j]; bv[r][j] = br[64 * j]; } }
#pragma unroll
        for (int r = 0; r < 2; ++r) {
            f32x4 hv[4]; float s = 0.f;
#pragma unroll
            for (int j = 0; j < 4; ++j) { const v2u w = hw[r][j]; hv[j] = (f32x4){bflo(w.x), bfhi(w.x), bflo(w.y), bfhi(w.y)};
                s += (hv[j].x * hv[j].x + hv[j].y * hv[j].y) + (hv[j].z * hv[j].z + hv[j].w * hv[j].w); }
            const float rstd = 1.0f / sqrtf(wave_sum(s) * (1.f / D) + EPS);
            float s2 = 0.f;
#pragma unroll
            for (int j = 0; j < 4; ++j) { hv[j] = bv[r][j] + hv[j] * rstd * gv[j]; s2 += (hv[j].x * hv[j].x + hv[j].y * hv[j].y) + (hv[j].z * hv[j].z + hv[j].w * hv[j].w); }
            f32x4* orow = (f32x4*)(xo + (size_t)(m + r) * D) + lane;
#pragma unroll
            for (int j = 0; j < 4; ++j) orow[64 * j] = hv[j];
            if (xn) {
                const float r2 = 1.0f / sqrtf(wave_sum(s2) * (1.f / D) + EPS);
                v2u* o8 = (v2u*)(xn + (size_t)(m + r) * D) + lane;
#pragma unroll
                for (int j = 0; j < 4; ++j) { v2u w; w.x = pk2(hv[j].x * r2, hv[j].y * r2); w.y = pk2(hv[j].z * r2, hv[j].w * r2); o8[64 * j] = w; }
            }
        }
    }
}
DI void y_rows(bf16* outraw, const bf16* proj, int gw, int NGW, int lane) {
    for (int m = gw; m < M; m += NGW) {
#pragma unroll
        for (int hh = 0; hh < 4; ++hh) {
            v4u* op = (v4u*)(outraw + (size_t)m * RV + hh * 512) + lane;
            const v4u ov = *op; const v4u gvv = *((const v4u*)(proj + (size_t)m * NPROJ + 4096 + hh * 512) + lane);
            float o[8] = {bflo(ov.x), bfhi(ov.x), bflo(ov.y), bfhi(ov.y), bflo(ov.z), bfhi(ov.z), bflo(ov.w), bfhi(ov.w)};
            float g[8] = {bflo(gvv.x), bfhi(gvv.x), bflo(gvv.y), bfhi(gvv.y), bflo(gvv.z), bfhi(gvv.z), bflo(gvv.w), bfhi(gvv.w)};
            float s = 0.f;
#pragma unroll
            for (int e = 0; e < 8; ++e) s += o[e] * o[e];
            const float rstd = 1.0f / sqrtf(wave_sum(s) * (1.f / 512.f) + EPS);
            v4u w; w.x = pk2(o[0] * rstd * g[0], o[1] * rstd * g[1]); w.y = pk2(o[2] * rstd * g[2], o[3] * rstd * g[3]);
            w.z = pk2(o[4] * rstd * g[4], o[5] * rstd * g[5]); w.w = pk2(o[6] * rstd * g[6], o[7] * rstd * g[7]);
            *op = w;
        }
    }
}
DI void combine_rows(const bf16* O0, const bf16* O1, const float* lamp, float lambda_init, bf16* on, int gw, int NGW, int lane) {
    const float a = lamp[lane] * lamp[64 + lane], b = lamp[128 + lane] * lamp[192 + lane];
    const float lam = expf(wave_sum(a)) - expf(wave_sum(b)) + lambda_init;
    for (int m = gw; m < M; m += NGW) {
        const v4u* p0 = (const v4u*)(O0 + (size_t)m * D) + 2 * lane; const v4u* p1 = (const v4u*)(O1 + (size_t)m * D) + 2 * lane;
        const v4u a0 = p0[0], a1 = p0[1], b0 = p1[0], b1 = p1[1];
        const unsigned aw[8] = {a0.x, a0.y, a0.z, a0.w, a1.x, a1.y, a1.z, a1.w}, bw[8] = {b0.x, b0.y, b0.z, b0.w, b1.x, b1.y, b1.z, b1.w};
        float o[16]; float s = 0.f;
#pragma unroll
        for (int e = 0; e < 8; ++e) { o[2 * e] = bflo(aw[e]) - lam * bflo(bw[e]); o[2 * e + 1] = bfhi(aw[e]) - lam * bfhi(bw[e]); s += o[2 * e] * o[2 * e] + o[2 * e + 1] * o[2 * e + 1]; }
        s += __shfl_xor(s, 1); s += __shfl_xor(s, 2); s += __shfl_xor(s, 4);
        const float rstd = 1.0f / sqrtf(s * (1.f / 128.f) + EPS);
        v4u w0, w1; w0.x = pk2(o[0] * rstd, o[1] * rstd); w0.y = pk2(o[2] * rstd, o[3] * rstd); w0.z = pk2(o[4] * rstd, o[5] * rstd); w0.w = pk2(o[6] * rstd, o[7] * rstd);
        w1.x = pk2(o[8] * rstd, o[9] * rstd); w1.y = pk2(o[10] * rstd, o[11] * rstd); w1.z = pk2(o[12] * rstd, o[13] * rstd); w1.w = pk2(o[14] * rstd, o[15] * rstd);
        v4u* op = (v4u*)(on + (size_t)m * D) + 2 * lane; op[0] = w0; op[1] = w1;
    }
}
DI void conv_rows(bf16* up, const bf16* side, const float* cw, const float* cb, int G, int vb, int tid) {
    if (tid >= FF / 8) return;
    const int c0 = tid * 8;
    float wg[3][8], wu[3][8], bg[8], bu[8];
#pragma unroll
    for (int j = 0; j < 3; ++j)
#pragma unroll
        for (int e = 0; e < 8; ++e) { wg[j][e] = cw[j * FF2 + c0 + e]; wu[j][e] = cw[j * FF2 + FF + c0 + e]; }
#pragma unroll
    for (int e = 0; e < 8; ++e) { bg[e] = cb[c0 + e]; bu[e] = cb[FF + c0 + e]; }
    for (int blk = vb; blk < M / 64; blk += G) {
        const int t0 = blk * 64;
        float g2[8], g1[8], u2[8], u1[8];
        if ((t0 & (SEQ - 1)) == 0) {
#pragma unroll
            for (int e = 0; e < 8; ++e) { g2[e] = 0.f; g1[e] = 0.f; u2[e] = 0.f; u1[e] = 0.f; }
        } else {
            const v4u a = *(const v4u*)(side + (size_t)((blk - 1) * 2 + 0) * FF + c0), b = *(const v4u*)(side + (size_t)((blk - 1) * 2 + 1) * FF + c0);
            const v4u c = *(const v4u*)(up + (size_t)(t0 - 2) * FF2 + FF + c0), d = *(const v4u*)(up + (size_t)(t0 - 1) * FF2 + FF + c0);
            const unsigned aw[4] = {a.x, a.y, a.z, a.w}, bw[4] = {b.x, b.y, b.z, b.w}, cw4[4] = {c.x, c.y, c.z, c.w}, dw[4] = {d.x, d.y, d.z, d.w};
#pragma unroll
            for (int e = 0; e < 4; ++e) { g2[2 * e] = bflo(aw[e]); g2[2 * e + 1] = bfhi(aw[e]); g1[2 * e] = bflo(bw[e]); g1[2 * e + 1] = bfhi(bw[e]);
                u2[2 * e] = bflo(cw4[e]); u2[2 * e + 1] = bfhi(cw4[e]); u1[2 * e] = bflo(dw[e]); u1[2 * e + 1] = bfhi(dw[e]); }
        }
        for (int t = t0; t < t0 + 64; t += 4) {
            v4u gr[4], ur[4];
#pragma unroll
            for (int i = 0; i < 4; ++i) { gr[i] = *(const v4u*)(up + (size_t)(t + i) * FF2 + c0); ur[i] = *(const v4u*)(up + (size_t)(t + i) * FF2 + FF + c0); }
#pragma unroll
            for (int i = 0; i < 4; ++i) {
                const unsigned gw4[4] = {gr[i].x, gr[i].y, gr[i].z, gr[i].w}, uw4[4] = {ur[i].x, ur[i].y, ur[i].z, ur[i].w};
                float gc[8], uc[8], act[8];
#pragma unroll
                for (int e = 0; e < 4; ++e) { gc[2 * e] = bflo(gw4[e]); gc[2 * e + 1] = bfhi(gw4[e]); uc[2 * e] = bflo(uw4[e]); uc[2 * e + 1] = bfhi(uw4[e]); }
#pragma unroll
                for (int e = 0; e < 8; ++e) {
                    const float hg = bg[e] + wg[0][e] * g2[e] + wg[1][e] * g1[e] + wg[2][e] * gc[e];
                    const float hu = bu[e] + wu[0][e] * u2[e] + wu[1][e] * u1[e] + wu[2][e] * uc[e];
                    act[e] = hg * __builtin_amdgcn_rcpf(1.0f + __expf(-hg)) * hu;
                    g2[e] = g1[e]; g1[e] = gc[e]; u2[e] = u1[e]; u1[e] = uc[e];
                }
                v4u w; w.x = pk2(act[0], act[1]); w.y = pk2(act[2], act[3]); w.z = pk2(act[4], act[5]); w.w = pk2(act[6], act[7]);
                *(v4u*)(up + (size_t)(t + i) * FF2 + c0) = w;
            }
        }
    }
}

DI bf16x8 tr_frag(LAS const unsigned char* lo, int hi_off) {
    const v4i16 a = __builtin_amdgcn_ds_read_tr16_b64_v4i16((LAS v4i16*)lo);
    const v4i16 b = __builtin_amdgcn_ds_read_tr16_b64_v4i16((LAS v4i16*)(lo + hi_off));
    return (bf16x8){a[0], a[1], a[2], a[3], b[0], b[1], b[2], b[3]};
}
#define MFMA16(a, b, c) __builtin_amdgcn_mfma_f32_16x16x32_bf16((a), (b), (c), 0, 0, 0)
DI void retention_phase(LAS unsigned char* lds, const bf16* proj, bf16* outraw, int G, int vcu) {
    int tid_l = threadIdx.x; asm volatile("" : "+v"(tid_l));
    const int tid = tid_l, lane = tid & 63, wid = __builtin_amdgcn_readfirstlane(tid >> 6);
    const int fr = lane & 15, fq = lane >> 4, q = fr >> 2, p = fr & 3;
    const int rb = wid < 4 ? wid : 11 - wid;
    constexpr int KROW = 528, VROW = 144, SROW = 144;
    constexpr int KS_OFF = 0, VS_OFF = 128 * KROW, SS_OFF = VS_OFF + 128 * VROW;
    static_assert(SS_OFF + 256 * SROW <= RING_BYTES, "retention LDS");
    LAS unsigned char* KS = lds + KS_OFF; LAS unsigned char* VS = lds + VS_OFF; LAS unsigned char* SS = lds + SS_OFF;
    for (int item = vcu; item < 256; item += G) {
        const int b = item >> 5, h = (item >> 3) & 3, es = item & 7;
        const float l2g = log2f(1.0f - exp2f(-5.0f - (float)h));
        const float cd = exp2f(l2g * 128.0f);
        for (int i = tid; i < 256 * SROW / 4; i += NWAVES * 64) ((LAS unsigned*)SS)[i] = 0u;
        f32x4 st[2][4];
#pragma unroll
        for (int mi = 0; mi < 2; ++mi)
#pragma unroll
            for (int nb = 0; nb < 4; ++nb) st[mi][nb] = (f32x4){0.f, 0.f, 0.f, 0.f};
        const bf16* Qg = proj + (size_t)(b * SEQ) * NPROJ + h * 256;
        const bf16* Kg = Qg + 1024;
        const bf16* Vg = proj + (size_t)(b * SEQ) * NPROJ + 2048 + h * 512 + es * 64;
        bf16* Og = outraw + (size_t)(b * SEQ) * RV + h * 512 + es * 64;
        for (int c = 0; c < 16; ++c) {
#pragma unroll
            for (int i = 0; i < 8; ++i) { const int pc = tid + 512 * i, row = pc >> 5, c16 = pc & 31;
                const v4u v = *(const v4u*)(Kg + (size_t)(c * 128 + row) * NPROJ + c16 * 8);
                *(LAS v4u*)(KS + row * KROW + c16 * 16) = v; }
#pragma unroll
            for (int i = 0; i < 2; ++i) { const int pc = tid + 512 * i, row = pc >> 3, c16 = pc & 7;
                const v4u v = *(const v4u*)(Vg + (size_t)(c * 128 + row) * NPROJ + c16 * 8);
                const float kd = exp2f(l2g * (float)(127 - row));
                v4u w; w.x = pk2(bflo(v.x) * kd, bfhi(v.x) * kd); w.y = pk2(bflo(v.y) * kd, bfhi(v.y) * kd); w.z = pk2(bflo(v.z) * kd, bfhi(v.z) * kd); w.w = pk2(bflo(v.w) * kd, bfhi(v.w) * kd);
                *(LAS v4u*)(VS + row * VROW + c16 * 16) = w; }
            bf16x8 Qf[8];
#pragma unroll
            for (int ks = 0; ks < 8; ++ks) Qf[ks] = *(const bf16x8*)(Qg + (size_t)(c * 128 + 16 * rb + fr) * NPROJ + ks * 32 + fq * 8);
            __syncthreads();
            f32x4 ao[4];
#pragma unroll
            for (int nb = 0; nb < 4; ++nb) ao[nb] = (f32x4){0.f, 0.f, 0.f, 0.f};
#pragma unroll
            for (int ks = 0; ks < 8; ++ks)
#pragma unroll
                for (int nb = 0; nb < 4; ++nb) { const bf16x8 B = tr_frag(SS + (32 * ks + 8 * fq + q) * SROW + (16 * nb + 4 * p) * 2, 4 * SROW); ao[nb] = MFMA16(Qf[ks], B, ao[nb]); }
#pragma unroll
            for (int kp = 0; kp < 4; ++kp) {
                if (2 * kp <= rb) {
                    f32x4 s0 = (f32x4){0.f, 0.f, 0.f, 0.f}, s1 = (f32x4){0.f, 0.f, 0.f, 0.f};
#pragma unroll
                    for (int ks = 0; ks < 8; ++ks) { const bf16x8 A = *(const LAS bf16x8*)(KS + (32 * kp + fr) * KROW + (32 * ks + 8 * fq) * 2); s0 = MFMA16(A, Qf[ks], s0); }
                    if (2 * kp == rb) {
#pragma unroll
                        for (int jj = 0; jj < 4; ++jj) if (4 * fq + jj > fr) s0[jj] = 0.f;
                    }
                    if (2 * kp + 1 <= rb) {
#pragma unroll
                        for (int ks = 0; ks < 8; ++ks) { const bf16x8 A = *(const LAS bf16x8*)(KS + (32 * kp + 16 + fr) * KROW + (32 * ks + 8 * fq) * 2); s1 = MFMA16(A, Qf[ks], s1); }
                        if (2 * kp + 1 == rb) {
#pragma unroll
                            for (int jj = 0; jj < 4; ++jj) if (4 * fq + jj > fr) s1[jj] = 0.f;
                        }
                    }
                    v4u pw; pw.x = pk2(s0[0], s0[1]); pw.y = pk2(s0[2], s0[3]); pw.z = pk2(s1[0], s1[1]); pw.w = pk2(s1[2], s1[3]);
                    const bf16x8 Pa = __builtin_bit_cast(bf16x8, pw);
#pragma unroll
                    for (int nb = 0; nb < 4; ++nb) { const bf16x8 B = tr_frag(VS + (32 * kp + 4 * fq + q) * VROW + (16 * nb + 4 * p) * 2, 16 * VROW); ao[nb] = MFMA16(Pa, B, ao[nb]); }
                }
            }
#pragma unroll
            for (int jj = 0; jj < 4; ++jj) { const int il = 16 * rb + 4 * fq + jj; const float sc = exp2f(l2g * (float)(il - 127));
                bf16* orow = Og + (size_t)(c * 128 + il) * RV + fr;
#pragma unroll
                for (int nb = 0; nb < 4; ++nb) orow[16 * nb] = (bf16)(pk2(ao[nb][jj] * sc, 0.f) & 0xffffu); }
#pragma unroll
            for (int mi = 0; mi < 2; ++mi)
#pragma unroll
                for (int nb = 0; nb < 4; ++nb) st[mi][nb] = st[mi][nb] * cd;
#pragma unroll
            for (int ks = 0; ks < 4; ++ks) {
                bf16x8 A[2], B[4];
#pragma unroll
                for (int mi = 0; mi < 2; ++mi) A[mi] = tr_frag(KS + (32 * ks + 8 * fq + q) * KROW + (16 * (2 * wid + mi) + 4 * p) * 2, 4 * KROW);
#pragma unroll
                for (int nb = 0; nb < 4; ++nb) B[nb] = tr_frag(VS + (32 * ks + 8 * fq + q) * VROW + (16 * nb + 4 * p) * 2, 4 * VROW);
#pragma unroll
                for (int mi = 0; mi < 2; ++mi)
#pragma unroll
                    for (int nb = 0; nb < 4; ++nb) st[mi][nb] = MFMA16(A[mi], B[nb], st[mi][nb]);
            }
            __syncthreads();
            if (c < 15) {
#pragma unroll
                for (int mi = 0; mi < 2; ++mi)
#pragma unroll
                    for (int nb = 0; nb < 4; ++nb)
#pragma unroll
                        for (int jj = 0; jj < 4; ++jj)
                            *(LAS unsigned short*)(SS + (16 * (2 * wid + mi) + 4 * fq + jj) * SROW + (16 * nb + fr) * 2) = (unsigned short)(pk2(st[mi][nb][jj] * cd, 0.f) & 0xffffu);
            }
        }
    }
}

typedef GAS unsigned gu32;
#define RLX_AGENT __ATOMIC_RELAXED, __HIP_MEMORY_SCOPE_AGENT
#define XB_TMO      128
#define XB_XCNT(j)  (256  + 64 * (j))
#define XB_XSUB(j)  (1280 + 64 * (j))
#define XB_XGEN(j)  (2304 + 64 * (j))
#define XB_TOP      3328
#define XB_TOPGEN   3392
#define XCD_BAR_WORDS 3456
#define XB_SPIN_CAP (1u << 18)

__device__ __forceinline__ unsigned xb_ld(unsigned* p)              { return __hip_atomic_load(p, __ATOMIC_RELAXED, __HIP_MEMORY_SCOPE_AGENT); }
__device__ __forceinline__ unsigned xb_add(unsigned* p, unsigned v) { return __hip_atomic_fetch_add(p, v, __ATOMIC_RELAXED, __HIP_MEMORY_SCOPE_AGENT); }
__device__ __forceinline__ unsigned xb_xcc_id() { return (unsigned)__builtin_amdgcn_s_getreg((3 << 11) | 20) & 0xFu; }
#define XB_SPIN(cond, bar) do { unsigned _sp = 0; while (cond) { __builtin_amdgcn_s_sleep(1); \
    if ((++_sp & 255u) == 0u) { if (xb_ld(&(bar)[XB_TMO])) break; if (_sp > XB_SPIN_CAP) { atomicAdd(&(bar)[XB_TMO], 1u); break; } } } } while (0)

struct XcdBarrier {
    unsigned* bar; unsigned x;
    volatile LAS unsigned* st;
};

__device__ __forceinline__ XcdBarrier xcd_barrier_post(unsigned* bar, volatile LAS unsigned* st) {
    XcdBarrier b; b.bar = bar; b.x = xb_xcc_id(); b.st = st;
    if (threadIdx.x == 0) (void)xb_add(&bar[XB_XCNT(b.x)], 1u);
    return b;
}
__device__ __forceinline__ void xcd_barrier_complete(unsigned* bar, unsigned x, unsigned& nloc, unsigned& nx) {
    const unsigned G = gridDim.x * gridDim.y * gridDim.z;
    unsigned sum, cnt, mine, sp = 0u;
    for (;;) {
        sum = 0u; cnt = 0u; mine = 0u;
#pragma unroll
        for (unsigned j = 0; j < 16; ++j) { const unsigned c = xb_ld(&bar[XB_XCNT(j)]); sum += c; cnt += (c > 0u) ? 1u : 0u; mine = (j == x) ? c : mine; }
        if (sum == G) break;
        __builtin_amdgcn_s_sleep(1);
        if ((++sp & 255u) == 0u) { if (xb_ld(&bar[XB_TMO])) break; if (sp > XB_SPIN_CAP) { atomicAdd(&bar[XB_TMO], 1u); break; } }
    }
    nloc = mine > 0u ? mine : 1u; nx = cnt > 0u ? cnt : 1u;
}

__device__ __forceinline__ void xcd_barrier(const XcdBarrier& b) {
    asm volatile("s_waitcnt vmcnt(0)" ::: "memory");
    __syncthreads();
    if (threadIdx.x == 0) {
        unsigned* bar = b.bar;
        __builtin_amdgcn_s_waitcnt(0);
        unsigned nloc = b.st[0], nx = b.st[1];
        if (nloc == 0u) { xcd_barrier_complete(bar, b.x, nloc, nx); b.st[0] = nloc; b.st[1] = nx; }
        const unsigned old = xb_add(&bar[XB_XSUB(b.x)], 1u);
        const unsigned gen = old / nloc;
        if (old + 1u == (gen + 1u) * nloc) {
            __builtin_amdgcn_fence(__ATOMIC_RELEASE, "agent");
            asm volatile("s_waitcnt vmcnt(0)" ::: "memory");
            const unsigned og = xb_add(&bar[XB_TOP], 1u);
            const unsigned tg = og / nx;
            if (og + 1u == (tg + 1u) * nx) xb_add(&bar[XB_TOPGEN], 1u);
            else XB_SPIN(xb_ld(&bar[XB_TOPGEN]) == tg, bar);
            __builtin_amdgcn_fence(__ATOMIC_ACQUIRE, "agent");
            xb_add(&bar[XB_XGEN(b.x)], 1u);
            asm volatile("s_waitcnt vmcnt(0)" ::: "memory");
        } else {
            XB_SPIN(xb_ld(&bar[XB_XGEN(b.x)]) == gen, bar);
            __builtin_amdgcn_fence(__ATOMIC_ACQUIRE, "agent");
            asm volatile("s_waitcnt vmcnt(0)" ::: "memory");
        }
    }
    __syncthreads();
}
constexpr int CW_BAR = 4096, MISC_OFF = LDS_BYTES - 2048;
constexpr int PTR_OFF = LDS_BYTES - 1024;
static_assert(8 * CONV_TILE <= LDS_BYTES - 2048, "conversion tiles vs LDS control words");
DI const float* inptr(LAS unsigned char* lds, int k) {
    volatile LAS unsigned* t = (volatile LAS unsigned*)(lds + PTR_OFF);
    const unsigned lo = __builtin_amdgcn_readfirstlane(t[2 * k]), hi = __builtin_amdgcn_readfirstlane(t[2 * k + 1]);
    return (const float*)(((unsigned long long)hi << 32) | (unsigned long long)lo);
}
#define PH_IDS int tid = threadIdx.x; asm volatile("" : "+v"(tid)); const int lane = tid & 63, wave = __builtin_amdgcn_readfirstlane(tid >> 6); \
    const int gw = vcu * NWAVES + wave, NGW = G * NWAVES; (void)lane; (void)gw; (void)NGW;
#define WPTR(off) ((bf16*)(ws + (off)))

#define FFN_PHASES(L, pb) \
        for (int rep = 0; rep < NREP(pb); ++rep) if (IN(pb)) { \
            pg8::Gemm g{(const bf16*)(ws + B_XN), WPTR(WS_WC), M, FF2, D, D}; pg8::StaticOrder S; S.init(M, FF2, G, bx); \
            pg8::EpiOut E{(bf16*)(ws + B_UP), FF2, 0, 0, 1.f, (bf16*)(ws + B_SIDE), FF / 256, FF}; \
            pg8::gemm_phase<pg8::EpiOut, pg8::StaticOrder, true, true>(lds + RING_OFF, g, S, E); \
        } \
        SEAM(pb); \
        if (IN(pb + 1)) { PH_IDS \
            conv_rows((bf16*)(ws + B_UP), (const bf16*)(ws + B_SIDE), inptr(lds, 16) + (size_t)L * 3 * FF2, inptr(lds, 17) + (size_t)L * FF2, G, vcu, tid); \
            if (L == 0) convert_matrix(inptr(lds, 15) + (size_t)D * FF2, D, FF2, WPTR(WS_WC), 0, inptr(lds, 13) + D, D, 1.f, lds, gw, NGW, wave, lane); \
            __syncthreads(); \
        } \
        SEAM(pb + 1); \
        for (int rep = 0; rep < NREP(pb + 2); ++rep) if (IN(pb + 2)) { \
            pg8::Gemm g{(const bf16*)(ws + B_UP), WPTR(WS_WD), M, D, FF, FF2}; pg8::StaticOrder S; S.init(M, D, G, bx); \
            pg8::EpiOut E{(bf16*)(ws + B_XN), D, 0, 0, 1.f, nullptr, 0, 0}; \
            pg8::gemm_phase<pg8::EpiOut, pg8::StaticOrder, true, true>(lds + RING_OFF, g, S, E); \
        } \
        SEAM(pb + 2); \
        if (IN(pb + 3)) { PH_IDS \
            resid_rows((const bf16*)(ws + B_XN), out, inptr(lds, 14) + (size_t)L * D, out, L == 0 ? (bf16*)(ws + B_XN2) : (bf16*)nullptr, gw, NGW, lane); \
            if (L == 0) convert_matrix(inptr(lds, 18) + (size_t)FF * D, FF, D, WPTR(WS_WD), 0, nullptr, FF, 1.f, lds, gw, NGW, wave, lane); \
            __syncthreads(); \
        }
struct Args { const float* in[19]; float* out; unsigned char* ws; int ph_lo, ph_hi; float lambda_init; int pad; };
__global__ void __launch_bounds__(NWAVES * 64, 2) yoco_fwd(Args args) {
    extern __shared__ __attribute__((aligned(16))) unsigned char lds_raw[];
    LAS unsigned char* lds = (LAS unsigned char*)lds_raw;
    const int G = gridDim.x; const int bx = blockIdx.x;
    const int vcu = (G % 8 == 0) ? (bx % 8) * (G / 8) + bx / 8 : bx;
    unsigned char* ws = args.ws;
    float* out = args.out;
    const int lo = args.ph_lo, hi = args.ph_hi;
    { const int t0 = threadIdx.x; if (t0 < 19) ((LAS unsigned long long*)(lds + PTR_OFF))[t0] = (unsigned long long)args.in[t0]; }
    if (threadIdx.x < 2) ((volatile LAS unsigned*)(lds + MISC_OFF))[threadIdx.x] = 0u;
    __syncthreads();
    XcdBarrier xbar; xbar.bar = (unsigned*)(ws + WS_CTL) + CW_BAR; xbar.x = 0; xbar.st = nullptr;
    if (N_LAUNCHES == 1) xbar = xcd_barrier_post((unsigned*)(ws + WS_CTL) + CW_BAR, (volatile LAS unsigned*)(lds + MISC_OFF));
#ifndef PHMASK
#define PHMASK 0x7ffff
#endif
#define IN(k) (((PHMASK >> ((k) > 14 ? (k) - 9 : (k))) & 1) && lo <= (k) && (k) < hi)
#ifndef PROBE_DUP
#define PROBE_DUP 0
#endif
#define NREP(k) (((PROBE_DUP >> (k)) & 1) ? 2 : 1)
#define SEAM(k) do { if (IN(k) && IN((k) + 1)) { xcd_barrier(xbar); } } while (0)

    for (int rep = 0; rep < NREP(0); ++rep) if (IN(0)) { PH_IDS
        float* cosT = (float*)(ws + WS_COS); float* sinT = (float*)(ws + WS_SIN);
        for (int i = (vcu * NWAVES * 64 + tid); i < SEQ * 128; i += G * NWAVES * 64) { const int pos = i >> 7, j = i & 127;
            const float inv = 1.0f / exp2f(13.287712379549449f * ((float)j / 127.0f)); const float ang = (float)pos * inv;
            const double rev = (double)ang * 0.15915494309189535; const float fr = (float)(rev - floor(rev));
            cosT[i] = __builtin_amdgcn_cosf(fr); sinT[i] = __builtin_amdgcn_sinf(fr); }
        convert_matrix(inptr(lds, 3), D, NPROJ, WPTR(WS_WA), 0, inptr(lds, 1), D, 1.f, lds, gw, NGW, wave, lane);
        convert_matrix(inptr(lds, 4), RV, D, WPTR(WS_WB), 0, nullptr, RV, 1.f, lds, gw, NGW, wave, lane);
        convert_matrix(inptr(lds, 15), D, FF2, WPTR(WS_WC), 0, inptr(lds, 13), D, 1.f, lds, gw, NGW, wave, lane);
        convert_matrix(inptr(lds, 18), FF, D, WPTR(WS_WD), 0, nullptr, FF, 1.f, lds, gw, NGW, wave, lane);
        norm_rows(inptr(lds, 0), (bf16*)out, gw, NGW, lane);
        __syncthreads();
    }
    SEAM(0);
    for (int rep = 0; rep < NREP(1); ++rep) if (IN(1)) {
        pg8::Gemm g{(const bf16*)out, WPTR(WS_WA), M, NPROJ, D, D}; pg8::StaticOrder S; S.init(M, NPROJ, G, bx);
        pg8::EpiProj E{(bf16*)(ws + B_PROJ), NPROJ, (const float*)(ws + WS_COS), (const float*)(ws + WS_SIN)};
        pg8::gemm_phase<pg8::EpiProj, pg8::StaticOrder, true, true>(lds + RING_OFF, g, S, E);
    }
    SEAM(1);
    for (int rep = 0; rep < NREP(2); ++rep) if (IN(2)) { retention_phase(lds + RING_OFF, (const bf16*)(ws + B_PROJ), (bf16*)out, G, vcu); __syncthreads(); }
    SEAM(2);
    if (IN(3)) { PH_IDS
        y_rows((bf16*)out, (const bf16*)(ws + B_PROJ), gw, NGW, lane);
        convert_matrix(inptr(lds, 9), D, D, WPTR(WS_WA), 0, inptr(lds, 7), D, 1.f, lds, gw, NGW, wave, lane);
        convert_matrix(inptr(lds, 6), D, 2 * D, WPTR(WS_WA), D, inptr(lds, 5), D, 1.f, lds, gw, NGW, wave, lane);
        convert_matrix(inptr(lds, 12), D, D, WPTR(WS_WA + 8 * MiB), 0, inptr(lds, 11), 128, 1.0f - args.lambda_init, lds, gw, NGW, wave, lane);
        __syncthreads();
    }
    SEAM(3);
    for (int rep = 0; rep < NREP(4); ++rep) if (IN(4)) {
        pg8::Gemm g{(const bf16*)out, WPTR(WS_WB), M, D, RV, RV}; pg8::StaticOrder S; S.init(M, D, G, bx);
        pg8::EpiOut E{(bf16*)(ws + B_H), D, 0, 0, 1.f, nullptr, 0, 0};
        pg8::gemm_phase<pg8::EpiOut, pg8::StaticOrder, true, true>(lds + RING_OFF, g, S, E);
    }
    SEAM(4);
    for (int rep = 0; rep < NREP(5); ++rep) if (IN(5)) { PH_IDS resid_rows((const bf16*)(ws + B_H), inptr(lds, 0), inptr(lds, 2), out, (bf16*)(ws + B_XN), gw, NGW, lane); }
    SEAM(5);
    FFN_PHASES(0, 6)
    SEAM(9);
    if (IN(10)) {
        pg8::Gemm g{(const bf16*)(ws + B_XN2), WPTR(WS_WA), M, 3 * D, D, D}; pg8::StaticOrder S; S.init(M, 3 * D, G, bx);
        pg8::EpiOut E{(bf16*)(ws + B_QKV), D, D, (size_t)M * D, attn_body::C2, nullptr, 0, 0};
        pg8::gemm_phase<pg8::EpiOut, pg8::StaticOrder, true, true>(lds + RING_OFF, g, S, E);
    }
    SEAM(10);
    for (int rep = 0; rep < NREP(11); ++rep) if (IN(11)) {
        const attn_body::bf16* Qp = (const attn_body::bf16*)(ws + B_QKV);
        const attn_body::AttnTensors AT{Qp, Qp + (size_t)M * D, Qp + (size_t)2 * M * D, (attn_body::bf16*)(ws + B_O0), (attn_body::bf16*)(ws + B_O1)};
        const attn_body::StaticOrder S((int)G, (int)bx);
        attn_body::attn_phase<attn_body::StaticOrder>((char*)lds_raw + RING_OFF, AT, S);
        __syncthreads();
    }
    SEAM(11);
    for (int rep = 0; rep < NREP(12); ++rep) if (IN(12)) { PH_IDS combine_rows((const bf16*)(ws + B_O0), (const bf16*)(ws + B_O1), inptr(lds, 10), args.lambda_init, (bf16*)(ws + B_ON), gw, NGW, lane); }
    SEAM(12);
    if (IN(13)) {
        pg8::Gemm g{(const bf16*)(ws + B_ON), WPTR(WS_WA + 8 * MiB), M, D, D, D}; pg8::StaticOrder S; S.init(M, D, G, bx);
        pg8::EpiOut E{(bf16*)(ws + B_H2), D, 0, 0, 1.f, nullptr, 0, 0};
        pg8::gemm_phase<pg8::EpiOut, pg8::StaticOrder, true, true>(lds + RING_OFF, g, S, E);
    }
    SEAM(13);
    if (IN(14)) { PH_IDS resid_rows((const bf16*)(ws + B_H2), out, inptr(lds, 8), out, (bf16*)(ws + B_XN), gw, NGW, lane); }
    SEAM(14);
    FFN_PHASES(1, 15)
#undef IN
#undef SEAM
}

extern "C" void kernel_launch(void* const* d_in, const int* in_sizes, int n_in, void* d_out, int out_size, void* d_ws, size_t ws_size, hipStream_t stream) {
    static int grid = 0;
    if (grid == 0) {
        if (n_in != 19 || in_sizes[0] != M * D || out_size != M * D || ws_size < WS_END) { fprintf(stderr, "kernel_launch: unexpected shapes (n_in %d, in0 %d, out %d, ws %zu); nothing launched\n", n_in, n_in > 0 ? in_sizes[0] : -1, out_size, ws_size); grid = -1; return; }
        int dev = 0, cus = 0, per_cu = 0;
        if (hipGetDevice(&dev) != hipSuccess || hipDeviceGetAttribute(&cus, hipDeviceAttributeMultiprocessorCount, dev) != hipSuccess) { grid = -1; return; }
        if (hipFuncSetAttribute((const void*)yoco_fwd, hipFuncAttributeMaxDynamicSharedMemorySize, LDS_BYTES) != hipSuccess) { fprintf(stderr, "kernel_launch: hipFuncSetAttribute failed\n"); grid = -1; return; }
        if (hipOccupancyMaxActiveBlocksPerMultiprocessor(&per_cu, (const void*)yoco_fwd, NWAVES * 64, LDS_BYTES) != hipSuccess || per_cu < 1) { fprintf(stderr, "kernel_launch: occupancy query says %d\n", per_cu); per_cu = 1; }
        (void)hipGetLastError();
        grid = cus;
    }
    if (grid < 0) return;
    if (hipMemsetAsync((char*)d_ws + WS_CTL, 0, 65536, stream) != hipSuccess) { fprintf(stderr, "kernel_launch: hipMemsetAsync failed\n"); return; }
    Args a{};
    for (int i = 0; i < 19; ++i) a.in[i] = (const float*)d_in[i];
    a.out = (float*)d_out; a.ws = (unsigned char*)d_ws;
    a.lambda_init = (float)(0.8 - 0.6 * exp(-0.3 * 1.0));
    if (N_LAUNCHES == 1) {
        a.ph_lo = 0; a.ph_hi = NPHASE;
        hipLaunchKernelGGL(yoco_fwd, dim3(grid), dim3(NWAVES * 64), LDS_BYTES, stream, a);
        const hipError_t le = hipPeekAtLastError();
        if (le != hipSuccess) fprintf(stderr, "kernel_launch: launch failed: %s (grid %d)\n", hipGetErrorName(le), grid);
    } else {
        for (int p = 0; p < NPHASE; ++p) {
            a.ph_lo = p; a.ph_hi = p + 1;
            hipLaunchKernelGGL(yoco_fwd, dim3(grid), dim3(NWAVES * 64), LDS_BYTES, stream, a);
            const hipError_t le = hipPeekAtLastError();
            if (le != hipSuccess) { fprintf(stderr, "kernel_launch: launch %d failed: %s\n", p, hipGetErrorName(le)); break; }
        }
    }
}
```

```cpp
#include <hip/hip_runtime.h>
#include <hip/hip_bf16.h>
#include <hip/hip_cooperative_groups.h>
#include <cstdio>
#include <cstdint>
#include <cmath>
namespace cg = cooperative_groups;

#ifndef MK_N_LAUNCHES
#define MK_N_LAUNCHES 1
#endif

namespace pg8 {
#define PG8_LAS __attribute__((address_space(3)))
typedef unsigned short bf16_t;
typedef short bf16x8 __attribute__((ext_vector_type(8)));
typedef float f32x4 __attribute__((ext_vector_type(4)));
typedef unsigned u32x4 __attribute__((ext_vector_type(4)));
constexpr int BM = 256, BK = 64, HALF = 128, HTB = HALF * BK * 2  , STAGE_BYTES = 8 * HTB, NXCD = 8, WGM = 8;

__host__ __device__ __forceinline__ int lds_byte(int r, int c) { const int st = (r >> 4) * 2 + (c >> 5), rr = r & 15, cc = c & 31, ob = rr * 64 + cc * 2; return st * 1024 + (ob ^ (((ob >> 9) & 1) << 5)); }
__host__ __device__ __forceinline__ void stage_rc(int b, int& R, int& C) { const int st = b / 1024, sb = b % 1024, swz = sb ^ (((sb >> 9) & 1) << 5); R = (st >> 1) * 16 + swz / 64; C = (st & 1) * 32 + (swz % 64) / 2; }
__host__ __device__ __forceinline__ int perm32(int rho) { const int n = rho >> 4, i = rho & 15; return 8 * (i >> 2) + 4 * n + (i & 3); }

struct Unit { int pm, pn; };
struct Gemm { const bf16_t* A; const bf16_t* Bt; int M, N, K, lda; };

struct StaticOrder {
    int nM, nN, nwg, G, c;
    __host__ __device__ void init(int M, int N, int G_, int c_) { nM = M / BM; nN = N / BM; nwg = nM * nN; G = G_; c = c_; }
    __host__ __device__ bool next(int i, Unit& u) const {
        const long L = (long)i * G + c; if (L >= nwg) return false;
        int wgid = (int)L; { const int q = nwg / NXCD, r = nwg % NXCD, xcd = wgid % NXCD, off = wgid / NXCD; wgid = (xcd < r ? xcd * (q + 1) : r * (q + 1) + (xcd - r) * q) + off; }
        const int nig = WGM * nN, gid = wgid / nig, fm = gid * WGM, gsz = (nM - fm) < WGM ? (nM - fm) : WGM;
        u.pm = fm + ((wgid % nig) % gsz); u.pn = (wgid % nig) / gsz; return true;
    }
    __device__ __forceinline__ void a_ready(const Unit&) const {}
    __device__ __forceinline__ void done(const Unit&) const {}
};

__device__ __forceinline__ unsigned cvt_pk_bf16(float lo, float hi) { unsigned r; asm volatile("v_cvt_pk_bf16_f32 %0, %1, %2" : "=v"(r) : "v"(lo), "v"(hi)); return r; }

struct EpiOut {
    static constexpr bool PERM = true, AFTER_DRAIN = false;
    bf16_t* O; int ldc; int split_cols; size_t split_stride; float scale0; bf16_t* side; int side_pn; int side_ld;
    __device__ __forceinline__ void operator()(const f32x4 (&acc)[2][2][4][2], const Unit& u, int wr, int wc, int fr, int fq) const {
        const int row0 = u.pm * BM + wr * 64 + fr; int colt = u.pn * BM; bf16_t* base = O;
        float sc = 1.f; if (split_cols) { const int t = colt / split_cols; base += (size_t)t * split_stride; colt -= t * split_cols; if (t == 0) sc = scale0; }
        const int col0 = colt + wc * 32 + 8 * fq;
        const bool do_side = (side != nullptr) && (u.pn < side_pn);
#pragma unroll
        for (int ai = 0; ai < 2; ++ai)
#pragma unroll
            for (int m = 0; m < 4; ++m) { const int row = row0 + ai * HALF + m * 16; bf16_t* rowp = base + (size_t)row * ldc + col0;
#pragma unroll
                for (int bj = 0; bj < 2; ++bj) { f32x4 v0 = acc[ai][bj][m][0] * sc, v1 = acc[ai][bj][m][1] * sc;
                    u32x4 w; w.x = cvt_pk_bf16(v0[0], v0[1]); w.y = cvt_pk_bf16(v0[2], v0[3]); w.z = cvt_pk_bf16(v1[0], v1[1]); w.w = cvt_pk_bf16(v1[2], v1[3]);
                    *(u32x4*)(rowp + bj * HALF) = w;
                    if (m == 3) { if (do_side && fr >= 14) *(u32x4*)(side + (size_t)((row >> 6) * 2 + (fr - 14)) * side_ld + col0 + bj * HALF) = w; } } }
    }
};

struct EpiProj {
    static constexpr bool PERM = true, AFTER_DRAIN = false;
    bf16_t* O; int ldc; const float* cosT; const float* sinT;
    __device__ __forceinline__ void operator()(const f32x4 (&acc)[2][2][4][2], const Unit& u, int wr, int wc, int fr, int fq) const {
        const int row0 = u.pm * BM + wr * 64 + fr; const int colt = u.pn * BM; const int j0 = wc * 32 + 8 * fq; const int col0 = colt + j0;
        const int kind = u.pn < 8 ? 0 : (u.pn < 16 ? 1 : 2);
        const float ksc = (u.pn >= 4) ? 0.0625f : 1.0f;
#pragma unroll
        for (int ai = 0; ai < 2; ++ai)
#pragma unroll
            for (int m = 0; m < 4; ++m) { const int row = row0 + ai * HALF + m * 16; bf16_t* rowp = O + (size_t)row * ldc + col0;
                f32x4 o[2][2];
                if (kind == 0) { const int pos = row & 2047;
#pragma unroll
                    for (int n = 0; n < 2; ++n) { const f32x4 c4 = *(const f32x4*)(cosT + pos * 128 + j0 + 4 * n), s4 = *(const f32x4*)(sinT + pos * 128 + j0 + 4 * n);
                        const f32x4 x1 = acc[ai][0][m][n], x2 = acc[ai][1][m][n];
                        o[0][n] = (x1 * c4 - x2 * s4) * ksc; o[1][n] = (x1 * s4 + x2 * c4) * ksc; }
                } else if (kind == 1) {
#pragma unroll
                    for (int bj = 0; bj < 2; ++bj)
#pragma unroll
                        for (int n = 0; n < 2; ++n) o[bj][n] = acc[ai][bj][m][n];
                } else {
#pragma unroll
                    for (int bj = 0; bj < 2; ++bj)
#pragma unroll
                        for (int n = 0; n < 2; ++n) { const f32x4 v = acc[ai][bj][m][n]; f32x4 r;
#pragma unroll
                            for (int e = 0; e < 4; ++e) r[e] = v[e] * __builtin_amdgcn_rcpf(1.0f + __expf(-v[e]));
                            o[bj][n] = r; }
                }
#pragma unroll
                for (int bj = 0; bj < 2; ++bj) { u32x4 w; w.x = cvt_pk_bf16(o[bj][0][0], o[bj][0][1]); w.y = cvt_pk_bf16(o[bj][0][2], o[bj][0][3]); w.z = cvt_pk_bf16(o[bj][1][0], o[bj][1][1]); w.w = cvt_pk_bf16(o[bj][1][2], o[bj][1][3]);
                    *(u32x4*)(rowp + bj * HALF) = w; } }
    }
};

template <class Epi, class Sched, bool ALIGN_EPI = false, bool SP2 = false>
__device__ __forceinline__ void gemm_phase(PG8_LAS unsigned char* lds, const Gemm g, const Sched& S, const Epi& E) {
    int tid_l = threadIdx.x; asm volatile("" : "+v"(tid_l)); const int tid = tid_l, wid = __builtin_amdgcn_readfirstlane(tid >> 6), lane = tid & 63, wr = wid >> 2, wc = wid & 3, fr = lane & 15, fq = lane >> 4;
    const int K = g.K, nt = K / BK;
    unsigned voffA[2], voffB[2];
#pragma unroll
    for (int i = 0; i < 2; ++i) { int R, C; stage_rc(tid * 16 + i * 8192, R, C); const int Rb = Epi::PERM ? ((R & ~31) + perm32(R & 31)) : R;
        voffA[i] = (unsigned)(R * g.lda + C) * 2u; voffB[i] = (unsigned)(Rb * K + C) * 2u; }
    const size_t kstep = (size_t)(BK * 2);
    const size_t hsB = (size_t)HALF * K * 2, hsA = (size_t)HALF * g.lda * 2;
    const size_t tsA = 2 * hsA, tsB = 2 * hsB;
    const unsigned ldsw = (unsigned)wid * 1024u;
    const int aoff = lds_byte(wr * 64 + fr, fq * 8), boff = lds_byte(wc * 32 + fr, fq * 8);
#define PG8_SA(b, h) (((b) * 2 + (h)) * HTB)
#define PG8_SB(b, h) ((4 + (b) * 2 + (h)) * HTB)
#define PG8_STAGE(bufoff, gbase, voff) do { _Pragma("unroll") for (int _i = 0; _i < 2; ++_i) \
        __builtin_amdgcn_global_load_lds((const unsigned*)((const char*)(gbase) + (voff)[_i]), (PG8_LAS unsigned*)(lds + (bufoff) + ldsw + _i * 8192), 16, 0, 0); } while (0)
#define PG8_LDA(dst, b, h) do { _Pragma("unroll") for (int m = 0; m < 4; ++m) _Pragma("unroll") for (int k = 0; k < 2; ++k) dst[m][k] = *(const PG8_LAS bf16x8*)(lds + PG8_SA(b, h) + aoff + m * 2048 + k * 1024); } while (0)
#define PG8_LDB(dst, b, h) do { _Pragma("unroll") for (int n = 0; n < 2; ++n) _Pragma("unroll") for (int k = 0; k < 2; ++k) dst[n][k] = *(const PG8_LAS bf16x8*)(lds + PG8_SB(b, h) + boff + n * 2048 + k * 1024); } while (0)
#define PG8_MMA(ai, bj, At, Bt) do { __builtin_amdgcn_s_setprio(1); _Pragma("unroll") for (int m = 0; m < 4; ++m) _Pragma("unroll") for (int n = 0; n < 2; ++n) _Pragma("unroll") for (int k = 0; k < 2; ++k) \
        acc[ai][bj][m][n] = __builtin_amdgcn_mfma_f32_16x16x32_bf16(Bt[n][k], At[m][k], acc[ai][bj][m][n], 0, 0, 0); __builtin_amdgcn_s_setprio(0); } while (0)
#define PG8_WAIT_V(n) asm volatile("s_waitcnt vmcnt(" #n ")" ::: "memory")
#define PG8_WAIT_L(n) asm volatile("s_waitcnt lgkmcnt(" #n ")" ::: "memory")
#define PG8_BAR __builtin_amdgcn_s_barrier()
#define PG8_SCHED __builtin_amdgcn_sched_barrier(0)
    Unit cur, nxt; int ui = 0;
    if (!S.next(0, cur)) return;
    f32x4 acc[2][2][4][2];
#pragma unroll
    for (int a = 0; a < 2; ++a)
#pragma unroll
        for (int b = 0; b < 2; ++b)
#pragma unroll
            for (int m = 0; m < 4; ++m)
#pragma unroll
                for (int n = 0; n < 2; ++n) acc[a][b][m][n] = (f32x4){0.f, 0.f, 0.f, 0.f};
    bf16x8 At[4][2], B0[2][2], B1[2][2];
    const char* cA = (const char*)g.A + (size_t)cur.pm * tsA; const char* cB = (const char*)g.Bt + (size_t)cur.pn * tsB;
    S.a_ready(cur);
    if constexpr (SP2) {
        PG8_STAGE(PG8_SB(0, 0), cB, voffB); PG8_STAGE(PG8_SB(0, 1), cB + hsB, voffB); PG8_STAGE(PG8_SA(0, 0), cA, voffA); PG8_STAGE(PG8_SA(0, 1), cA + hsA, voffA);
        if (wr == 1) PG8_BAR;
        PG8_WAIT_V(2); PG8_BAR;
        PG8_STAGE(PG8_SB(1, 0), cB + kstep, voffB); PG8_STAGE(PG8_SA(1, 0), cA + kstep, voffA); PG8_STAGE(PG8_SB(1, 1), cB + hsB + kstep, voffB);
        PG8_WAIT_V(6); PG8_BAR;
    } else {
        PG8_STAGE(PG8_SB(0, 0), cB, voffB); PG8_STAGE(PG8_SA(0, 0), cA, voffA); PG8_STAGE(PG8_SB(0, 1), cB + hsB, voffB); PG8_STAGE(PG8_SA(0, 1), cA + hsA, voffA);
        if (wr == 1) PG8_BAR;
        PG8_WAIT_V(4); PG8_BAR;
        PG8_STAGE(PG8_SB(1, 0), cB + kstep, voffB); PG8_STAGE(PG8_SA(1, 0), cA + kstep, voffA); PG8_STAGE(PG8_SB(1, 1), cB + hsB + kstep, voffB);
        PG8_WAIT_V(6); PG8_BAR;
    }
    for (;;) {
        const bool has_next = S.next(ui + 1, nxt);
        const char* nA = has_next ? (const char*)g.A + (size_t)nxt.pm * tsA : cA; const char* nB = has_next ? (const char*)g.Bt + (size_t)nxt.pn * tsB : cB;
        for (int t = 0; t < nt; t += 2) {
            const bool last = (t == nt - 2);
            const char* a1 = cA + (size_t)(t + 1) * kstep;
            const char* a2 = last ? nA : cA + (size_t)(t + 2) * kstep; const char* b2 = last ? nB : cB + (size_t)(t + 2) * kstep;
            const char* a3 = a2 + kstep; const char* b3 = b2 + kstep;
            if (last && has_next) S.a_ready(nxt);
            if constexpr (SP2) {
            PG8_LDB(B0, 0, 0); PG8_LDB(B1, 0, 1); PG8_SCHED; PG8_LDA(At, 0, 0); PG8_STAGE(PG8_SA(1, 1), a1 + hsA, voffA);
            PG8_WAIT_V(8); PG8_WAIT_L(0); PG8_BAR; PG8_MMA(0, 0, At, B0); PG8_MMA(0, 1, At, B1); PG8_BAR; PG8_SCHED;
            PG8_LDA(At, 0, 1); PG8_STAGE(PG8_SB(0, 0), b2, voffB); PG8_STAGE(PG8_SB(0, 1), b2 + hsB, voffB); PG8_STAGE(PG8_SA(0, 0), a2, voffA);
            PG8_WAIT_V(8); PG8_WAIT_L(0); PG8_BAR; PG8_MMA(1, 0, At, B0); PG8_MMA(1, 1, At, B1); PG8_BAR; PG8_SCHED;
            PG8_LDB(B0, 1, 0); PG8_LDB(B1, 1, 1); PG8_SCHED; PG8_LDA(At, 1, 0); PG8_STAGE(PG8_SA(0, 1), a2 + hsA, voffA);
            PG8_WAIT_V(8); PG8_WAIT_L(0); PG8_BAR; PG8_MMA(0, 0, At, B0); PG8_MMA(0, 1, At, B1); PG8_BAR; PG8_SCHED;
            PG8_LDA(At, 1, 1); PG8_STAGE(PG8_SB(1, 0), b3, voffB); PG8_STAGE(PG8_SB(1, 1), b3 + hsB, voffB); PG8_STAGE(PG8_SA(1, 0), a3, voffA);
            PG8_WAIT_V(8); PG8_WAIT_L(0); PG8_BAR; PG8_MMA(1, 0, At, B0); PG8_MMA(1, 1, At, B1); PG8_BAR; PG8_SCHED;
            } else {
            PG8_LDB(B0, 0, 0); PG8_SCHED; PG8_LDA(At, 0, 0); PG8_STAGE(PG8_SA(1, 1), a1 + hsA, voffA);
            PG8_WAIT_L(8); PG8_BAR; PG8_WAIT_L(0); PG8_MMA(0, 0, At, B0); PG8_BAR; PG8_SCHED;
            PG8_LDB(B1, 0, 1); PG8_STAGE(PG8_SB(0, 0), b2, voffB);
            PG8_BAR; PG8_WAIT_L(0); PG8_MMA(0, 1, At, B1); PG8_BAR;
            PG8_LDA(At, 0, 1); PG8_STAGE(PG8_SA(0, 0), a2, voffA);
            PG8_BAR; PG8_WAIT_L(0); PG8_MMA(1, 0, At, B0); PG8_BAR; PG8_SCHED;
            PG8_STAGE(PG8_SB(0, 1), b2 + hsB, voffB);
            PG8_WAIT_V(6); PG8_BAR; PG8_MMA(1, 1, At, B1); PG8_BAR;
            PG8_LDB(B0, 1, 0); PG8_SCHED; PG8_LDA(At, 1, 0); PG8_STAGE(PG8_SA(0, 1), a2 + hsA, voffA);
            PG8_WAIT_L(8); PG8_BAR; PG8_WAIT_L(0); PG8_MMA(0, 0, At, B0); PG8_BAR; PG8_SCHED;
            PG8_LDB(B1, 1, 1); PG8_STAGE(PG8_SB(1, 0), b3, voffB);
            PG8_BAR; PG8_WAIT_L(0); PG8_MMA(0, 1, At, B1); PG8_BAR;
            PG8_LDA(At, 1, 1); PG8_STAGE(PG8_SA(1, 0), a3, voffA);
            PG8_BAR; PG8_WAIT_L(0); PG8_MMA(1, 0, At, B0); PG8_BAR; PG8_SCHED;
            PG8_STAGE(PG8_SB(1, 1), b3 + hsB, voffB);
            PG8_WAIT_V(6); PG8_BAR; PG8_MMA(1, 1, At, B1); PG8_BAR;
            }
        }
        if constexpr (ALIGN_EPI) { if (wr == 0) PG8_BAR; }
        if constexpr (!Epi::AFTER_DRAIN) { E(acc, cur, wr, wc, fr, fq); S.done(cur); }
        if (!has_next) break;
#pragma unroll
        for (int a = 0; a < 2; ++a)
#pragma unroll
            for (int b = 0; b < 2; ++b)
#pragma unroll
                for (int m = 0; m < 4; ++m)
#pragma unroll
                    for (int n = 0; n < 2; ++n) acc[a][b][m][n] = (f32x4){0.f, 0.f, 0.f, 0.f};
        cur = nxt; cA = nA; cB = nB; ++ui;
        if constexpr (ALIGN_EPI) { if (wr == 1) PG8_BAR; }
    }
    PG8_WAIT_V(0);
    if constexpr (!ALIGN_EPI) { if (wr == 0) PG8_BAR; }
    PG8_BAR;
    if constexpr (Epi::AFTER_DRAIN) { E.fused(acc, cur, wr, wc, fr, fq, lds, wid, lane); S.done(cur); }
#undef PG8_SA
#undef PG8_SB
#undef PG8_STAGE
#undef PG8_LDA
#undef PG8_LDB
#undef PG8_MMA
#undef PG8_WAIT_V
#undef PG8_WAIT_L
#undef PG8_BAR
#undef PG8_SCHED
}
}
namespace attn_body {
using bf16=__hip_bfloat16;
using bf16x8=__attribute__((ext_vector_type(8)))short;
using s16x4=__attribute__((ext_vector_type(4)))short;
using f32x16=__attribute__((ext_vector_type(16)))float;
using u32x4=__attribute__((ext_vector_type(4)))unsigned;
constexpr int BATCH=8,NHEAD=16,SEQ=2048,D=64,DM=1024;
constexpr int NW=8,QBLK=32,QB=QBLK*NW,KVBLK=64,NQB=SEQ/QB;
constexpr int ATTN_PITCH=DM, ATTN_UNIT_ROWS=QB;
__device__ __forceinline__ int crow(int r,int hi){return (r&3)+8*(r>>2)+4*hi;}
#define SBAR() __builtin_amdgcn_sched_barrier(0)
__device__ __forceinline__ void cmask(f32x16&p0,f32x16&p1,int jb,int qrel,int hi){
  const float NEG=-INFINITY; int kb=64*jb+4*hi;
  #pragma unroll
  for(int r=0;r<16;++r){int kv=kb+(r&3)+8*(r>>2); if(kv>qrel)p0[r]=NEG; if(kv+32>qrel)p1[r]=NEG;}
}

constexpr int NSLOT=3, SLOTB=8192;
constexpr int LDS_K=0, LDS_V=NSLOT*SLOTB, LDS_WS=2*NSLOT*SLOTB, LDS_OST=LDS_WS+NW*64*4, LDS_BYTES=LDS_OST+NW*4096;
constexpr float C2=0.125f*1.4426950408889634f;
__device__ __forceinline__ void glds16(const void*gsrc,unsigned lds_dst){unsigned keep;
  asm volatile("s_mov_b32 %0, m0\n\ts_mov_b32 m0, %2\n\ts_nop 0\n\tglobal_load_lds_dwordx4 %1, off\n\ts_mov_b32 m0, %0":"=&s"(keep):"v"(gsrc),"s"(lds_dst):"memory");}
__device__ __forceinline__ float max3f(float a,float b,float c){float r;asm("v_max3_f32 %0, %1, %2, %3":"=v"(r):"v"(a),"v"(b),"v"(c));return r;}
__device__ __forceinline__ float max2f(float a,float b){float r;asm("v_max_f32_e32 %0, %1, %2":"=v"(r):"v"(a),"v"(b));return r;}
__device__ __forceinline__ float fadd_s(float a,float b){float r;asm("v_add_f32_e32 %0, %1, %2":"=v"(r):"v"(a),"v"(b));return r;}
__device__ __forceinline__ float fsub_s(float a,float b){float r;asm("v_sub_f32_e32 %0, %1, %2":"=v"(r):"v"(a),"v"(b));return r;}
typedef float f32x2_t __attribute__((ext_vector_type(2))); typedef __bf16 bf16x2_t __attribute__((ext_vector_type(2)));
__device__ __forceinline__ unsigned cvtpk_s(float lo,float hi){f32x2_t v={lo,hi};bf16x2_t b=__builtin_convertvector(v,bf16x2_t);return __builtin_bit_cast(unsigned,b);}
#define WAIT_BAR(N) asm volatile("s_waitcnt vmcnt(" #N ") lgkmcnt(0)\n\ts_barrier":::"memory")

__device__ __forceinline__ void qkt(f32x16&p0,f32x16&p1,const char*Kslot,const bf16x8*qr,const f32x16&negm,int r32,int hi){
  const char*kb=Kslot+hi*1024+r32*16;
  #pragma unroll
  for(int d0=0;d0<4;++d0){
    const bf16x8 b0=*reinterpret_cast<const bf16x8*>(kb+d0*2048);
    const bf16x8 b1=*reinterpret_cast<const bf16x8*>(kb+d0*2048+512);
    if(d0==0){p0=__builtin_amdgcn_mfma_f32_32x32x16_bf16(b0,qr[0],negm,0,0,0);p1=__builtin_amdgcn_mfma_f32_32x32x16_bf16(b1,qr[0],negm,0,0,0);}
    else{p0=__builtin_amdgcn_mfma_f32_32x32x16_bf16(b0,qr[d0],p0,0,0,0);p1=__builtin_amdgcn_mfma_f32_32x32x16_bf16(b1,qr[d0],p1,0,0,0);}}
}
typedef __attribute__((address_space(3))) const char* lds_cptr;
typedef short v4i16_t __attribute__((ext_vector_type(4)));
__device__ __forceinline__ void kload8(bf16x8*kf,lds_cptr kp){
  kf[0]=*(const __attribute__((address_space(3))) bf16x8*)(kp);      kf[1]=*(const __attribute__((address_space(3))) bf16x8*)(kp+512);
  kf[2]=*(const __attribute__((address_space(3))) bf16x8*)(kp+2048); kf[3]=*(const __attribute__((address_space(3))) bf16x8*)(kp+2560);
  kf[4]=*(const __attribute__((address_space(3))) bf16x8*)(kp+4096); kf[5]=*(const __attribute__((address_space(3))) bf16x8*)(kp+4608);
  kf[6]=*(const __attribute__((address_space(3))) bf16x8*)(kp+6144); kf[7]=*(const __attribute__((address_space(3))) bf16x8*)(kp+6656);
}
__device__ __forceinline__ void kload2(bf16x8*kf,lds_cptr kp,int j){ kf[2*j]=*(const __attribute__((address_space(3))) bf16x8*)(kp+j*2048); kf[2*j+1]=*(const __attribute__((address_space(3))) bf16x8*)(kp+j*2048+512); }
__device__ __forceinline__ s16x4 vtr(lds_cptr p){ return __builtin_bit_cast(s16x4,__builtin_amdgcn_ds_read_tr16_b64_v4i16((__attribute__((address_space(3))) v4i16_t*)p)); }
__device__ __forceinline__ float rowmax(const f32x16&p0,const f32x16&p1){
  float a=max3f(p0[0],p0[1],p1[0]),b=max3f(p0[2],p0[3],p1[1]);a=max3f(a,p1[2],p1[3]);
  #pragma unroll
  for(int r=4;r<16;r+=4){a=max3f(a,p0[r],p0[r+1]);b=max3f(b,p0[r+2],p0[r+3]);a=max3f(a,p1[r],p1[r+1]);b=max3f(b,p1[r+2],p1[r+3]);}
  const float m=max2f(a,b);
  auto rr=__builtin_amdgcn_permlane32_swap(__float_as_uint(m),__float_as_uint(m),false,false);
  return max2f(__uint_as_float(rr[0]),__uint_as_float(rr[1]));
}
__device__ __forceinline__ void pv(f32x16*o,int vb,bf16x8 pa0,bf16x8 pa1,bf16x8 pa2,bf16x8 pa3){
  #pragma unroll
  for(int d0=0;d0<2;++d0){s16x4 lo[4],hi[4];
    #pragma unroll
    for(int ks=0;ks<4;++ks){
      asm volatile("ds_read_b64_tr_b16 %0,%1 offset:%c2":"=&v"(lo[ks]):"v"(vb),"i"(d0*4096+ks*1024):"memory");
      asm volatile("ds_read_b64_tr_b16 %0,%1 offset:%c2":"=&v"(hi[ks]):"v"(vb),"i"(d0*4096+ks*1024+512):"memory");}
    asm volatile("s_waitcnt lgkmcnt(0)":::"memory");SBAR();
    #define PK(k) (bf16x8){lo[k][0],lo[k][1],lo[k][2],lo[k][3],hi[k][0],hi[k][1],hi[k][2],hi[k][3]}
    o[d0]=__builtin_amdgcn_mfma_f32_32x32x16_bf16(pa0,PK(0),o[d0],0,0,0);
    o[d0]=__builtin_amdgcn_mfma_f32_32x32x16_bf16(pa1,PK(1),o[d0],0,0,0);
    o[d0]=__builtin_amdgcn_mfma_f32_32x32x16_bf16(pa2,PK(2),o[d0],0,0,0);
    o[d0]=__builtin_amdgcn_mfma_f32_32x32x16_bf16(pa3,PK(3),o[d0],0,0,0);
    #undef PK
  }
}

#ifndef ATTN_STORE16
#define ATTN_STORE16(p,v) (*(u32x4*)(p)=(v))
#endif
template<int THRL> __device__ __forceinline__ void attn_unit(int b,int qkcol,int vcol,int qb,const bf16*Q,const bf16*__restrict__ K,const bf16*__restrict__ V,bf16*O,char*shm){
  const int tid=threadIdx.x,lane=tid&63,r32=lane&31,hi=lane>>5; const int wid=__builtin_amdgcn_readfirstlane(tid>>6);
  const long rowbase=(long)b*SEQ; const int q0=qb*QB;
  const bf16*Qw=Q+(rowbase+q0+wid*QBLK)*DM+qkcol;
  const bf16*Kh=K+rowbase*DM+qkcol,*Vh=V+rowbase*DM+vcol;
  const unsigned lds0=(unsigned)(uintptr_t)shm;
  float*wsf=(float*)(shm+LDS_WS)+wid*64;
  const bf16*ksrc=Kh+(long)lane*DM+wid*8;
  const bf16*vsrc=Vh+(long)(16*(wid&3)+(lane>>2))*DM+(wid>>2)*32+(lane&3)*8;
  const unsigned kdst=lds0+LDS_K+wid*1024, vdst=lds0+LDS_V+wid*1024;
  #define DMA_K(t,slot) glds16(ksrc+(long)(t)*KVBLK*DM,(unsigned)__builtin_amdgcn_readfirstlane(kdst+(slot)))
  #define DMA_V(t,slot) glds16(vsrc+(long)(t)*KVBLK*DM,(unsigned)__builtin_amdgcn_readfirstlane(vdst+(slot)))
  const int vb0=(int)(lds0+LDS_V)+((lane>>4)&1)*32+(lane&3)*8+(4*hi+((lane&15)>>2))*64;
  const char*Kbase=shm+LDS_K; bf16x8 kf[8];
  const lds_cptr shm3=(lds_cptr)shm; const lds_cptr kp0=shm3+LDS_K+hi*1024+r32*16; const lds_cptr vp0=shm3+LDS_V+((lane>>4)&1)*32+(lane&3)*8+(4*hi+((lane&15)>>2))*64;
  const int NT=(q0+QB)/KVBLK;
  DMA_K(0,0);DMA_V(0,0);DMA_K(1,SLOTB);
  bf16x8 qr[4];
  #pragma unroll
  for(int d0=0;d0<4;++d0)qr[d0]=*reinterpret_cast<const bf16x8*>(&Qw[(long)r32*DM+d0*16+hi*8]);
  float mhat=0.f,l_reg=0.f;f32x16 o[2];o[0]=f32x16{};o[1]=f32x16{};f32x16 negm=f32x16{};asm volatile("":"+v"(negm));
  const int qrel=wid*QBLK+r32;
  #define CMASK(P0,P1,t) do{int jb_=(t)-(NT-4); if(jb_>=0)cmask(P0,P1,jb_,qrel,hi);}while(0)
  bool resc=false;
  #define START(P0,P1) do{ const float rm=rowmax(P0,P1); resc=false; \
    { const float dl=rm; mhat=fadd_s(mhat,dl); \
      _Pragma("unroll") for(int r=0;r<16;++r){P0[r]=fsub_s(P0[r],dl);P1[r]=fsub_s(P1[r],dl);} \
      _Pragma("unroll") for(int r=0;r<16;++r)negm[r]=-mhat; asm volatile("":"+v"(negm)); } \
    _Pragma("unroll") for(int r=0;r<16;++r)P0[r]=__builtin_amdgcn_exp2f(P0[r]); }while(0)
  #define RESC() do{ if(resc){ asm volatile("s_waitcnt lgkmcnt(0)":::"memory"); \
      _Pragma("unroll") for(int d_=0;d_<2;++d_) _Pragma("unroll") for(int r=0;r<16;++r)o[d_][r]*=wsf[crow(r,hi)]; } }while(0)
  f32x16 pA0,pA1,pB0,pB1;
  int sl_prev=0,sl_cur=0,sl_next=SLOTB;
  #define ROT() do{sl_prev=sl_cur;sl_cur=sl_next;sl_next=(sl_next==(NSLOT-1)*SLOTB)?0:sl_next+SLOTB;}while(0)
  DMA_K(2,2*SLOTB);
  WAIT_BAR(3);
  qkt(pA0,pA1,Kbase,qr,negm,r32,hi);asm volatile("s_nop 15\n\ts_nop 7":"+v"(pA0),"+v"(pA1));CMASK(pA0,pA1,0);
  START(pA0,pA1);
  _Pragma("unroll") for(int r=0;r<16;++r)pA1[r]=__builtin_amdgcn_exp2f(pA1[r]);
  WAIT_BAR(0);
  DMA_K(3,0);DMA_V(1,SLOTB);
  ROT();
  kload8(kf,kp0+sl_cur);
  WAIT_BAR(2);
  s16x4 vlo[8],vhi[8]; u32x4 pw0,pw1,pw2,pw3;
  #define PKW(P,B) cvtpk_s(P[B],P[B+1])
  #define PAF(k) __builtin_bit_cast(bf16x8,pw##k)
  #define VFR(i) (bf16x8){vlo[i][0],vlo[i][1],vlo[i][2],vlo[i][3],vhi[i][0],vhi[i][1],vhi[i][2],vhi[i][3]}
  #define PIN(x) asm volatile("":"+v"(x))
  #define MX3(a,b,c) __builtin_fmaxf(__builtin_fmaxf((a),(b)),(c))
  #define GAPA(MF,A0,A1,A2,A3,W0,W1,PW) do{ MF; sacc+=A0; sacc+=A1; sacc+=A2; sacc+=A3; PIN(sacc); W0; W1; PIN(PW); SBAR(); }while(0)
  #define EX(v) __builtin_amdgcn_exp2f(v)
  #define GAPB(MF,X,B) do{ MF; X[B]=EX(X[B]); X[B+1]=EX(X[B+1]); X[B+2]=EX(X[B+2]); X[B+3]=EX(X[B+3]); PIN(X); SBAR(); }while(0)
  #define VRD(i) do{ vlo[i]=vtr(vp_+(((i)>>2)*4096+((i)&3)*1024)); vhi[i]=vtr(vp_+(((i)>>2)*4096+((i)&3)*1024+512)); }while(0)
  #define KRD(G,j) do{ if(G){ kload2(kf,kp0+sl_next,j); SBAR(); } }while(0)
  #define STEP(C0,C1,P0,P1,t,GK,GV,GL) do{ SBAR(); \
    const lds_cptr vp_=vp0+sl_prev; \
    VRD(0); SBAR(); float sacc=(P0[0]+P0[1]); \
    GAPA(C0=__builtin_amdgcn_mfma_f32_32x32x16_bf16(kf[0],qr[0],negm,0,0,0), P0[2],P0[3],P0[4],P0[5],     pw0[0]=PKW(P0,0), pw0[1]=PKW(P0,2), pw0); \
    VRD(4); SBAR(); GAPA(C1=__builtin_amdgcn_mfma_f32_32x32x16_bf16(kf[1],qr[0],negm,0,0,0), P0[6],P0[7],P0[8],P0[9],     pw0[2]=PKW(P0,4), pw0[3]=PKW(P0,6), pw0); \
    VRD(1); SBAR(); GAPA(C0=__builtin_amdgcn_mfma_f32_32x32x16_bf16(kf[2],qr[1],C0,0,0,0),   P0[10],P0[11],P0[12],P0[13], pw1[0]=PKW(P0,8), pw1[1]=PKW(P0,10), pw1); \
    VRD(5); SBAR(); GAPA(C1=__builtin_amdgcn_mfma_f32_32x32x16_bf16(kf[3],qr[1],C1,0,0,0),   P0[14],P0[15],P1[0],P1[1],   pw1[2]=PKW(P0,12),pw1[3]=PKW(P0,14), pw1); \
    VRD(2); SBAR(); GAPA(C0=__builtin_amdgcn_mfma_f32_32x32x16_bf16(kf[4],qr[2],C0,0,0,0),   P1[2],P1[3],P1[4],P1[5],     pw2[0]=PKW(P1,0), pw2[1]=PKW(P1,2), pw2); \
    VRD(6); SBAR(); GAPA(C1=__builtin_amdgcn_mfma_f32_32x32x16_bf16(kf[5],qr[2],C1,0,0,0),   P1[6],P1[7],P1[8],P1[9],     pw2[2]=PKW(P1,4), pw2[3]=PKW(P1,6), pw2); \
    VRD(3); SBAR(); GAPA(C0=__builtin_amdgcn_mfma_f32_32x32x16_bf16(kf[6],qr[3],C0,0,0,0),   P1[10],P1[11],P1[12],P1[13], pw3[0]=PKW(P1,8), pw3[1]=PKW(P1,10), pw3); \
    VRD(7); SBAR(); GAPA(C1=__builtin_amdgcn_mfma_f32_32x32x16_bf16(kf[7],qr[3],C1,0,0,0),   P1[14],P1[15],0.f,0.f,       pw3[2]=PKW(P1,12),pw3[3]=PKW(P1,14), pw3); \
    l_reg+=sacc; \
    if(GK){DMA_K((t)+3,sl_cur);} if(GV){DMA_V((t)+1,sl_next);} \
    CMASK(C0,C1,t); \
    { float a=MX3(C0[0],C0[1],C1[0]),b=MX3(C0[2],C0[3],C1[1]); a=MX3(a,C1[2],C1[3]); \
      _Pragma("unroll") for(int r=4;r<16;r+=4){a=MX3(a,C0[r],C0[r+1]);b=MX3(b,C0[r+2],C0[r+3]);a=MX3(a,C1[r],C1[r+1]);b=MX3(b,C1[r+2],C1[r+3]);} \
      float rm=__builtin_fmaxf(a,b); { auto rr=__builtin_amdgcn_permlane32_swap(__float_as_uint(rm),__float_as_uint(rm),false,false); rm=__builtin_fmaxf(__uint_as_float(rr[0]),__uint_as_float(rr[1])); } \
      resc=false; \
      if(__builtin_expect(__any(rm>(float)THRL),0)){ const float dl=__builtin_fmaxf(rm,0.f); mhat+=dl; \
        _Pragma("unroll") for(int r=0;r<16;++r){C0[r]-=dl;C1[r]-=dl;} \
        _Pragma("unroll") for(int r=0;r<16;++r)negm[r]=-mhat; asm volatile("":"+v"(negm)); \
        const float f=__builtin_amdgcn_exp2f(-dl); l_reg*=f; if(hi==0)wsf[r32]=f; resc=true; } } \
    SBAR(); \
    GAPB(o[0]=__builtin_amdgcn_mfma_f32_32x32x16_bf16(PAF(0),VFR(0),o[0],0,0,0), C0,0); \
    GAPB(o[1]=__builtin_amdgcn_mfma_f32_32x32x16_bf16(PAF(0),VFR(4),o[1],0,0,0), C0,4); \
    KRD(GL,0); GAPB(o[0]=__builtin_amdgcn_mfma_f32_32x32x16_bf16(PAF(1),VFR(1),o[0],0,0,0), C0,8); \
    KRD(GL,1); GAPB(o[1]=__builtin_amdgcn_mfma_f32_32x32x16_bf16(PAF(1),VFR(5),o[1],0,0,0), C0,12); \
    KRD(GL,2); GAPB(o[0]=__builtin_amdgcn_mfma_f32_32x32x16_bf16(PAF(2),VFR(2),o[0],0,0,0), C1,0); \
    KRD(GL,3); GAPB(o[1]=__builtin_amdgcn_mfma_f32_32x32x16_bf16(PAF(2),VFR(6),o[1],0,0,0), C1,4); \
    GAPB(o[0]=__builtin_amdgcn_mfma_f32_32x32x16_bf16(PAF(3),VFR(3),o[0],0,0,0), C1,8); \
    GAPB(o[1]=__builtin_amdgcn_mfma_f32_32x32x16_bf16(PAF(3),VFR(7),o[1],0,0,0), C1,12); \
    }while(0)
  int t=1;
  #undef CMASK
  #define CMASK(P0,P1,t) do{}while(0)
  for(;t+5<NT;t+=2){
    STEP(pB0,pB1,pA0,pA1,t,true,true,true);     WAIT_BAR(2); RESC(); ROT();
    STEP(pA0,pA1,pB0,pB1,t+1,true,true,true);   WAIT_BAR(2); RESC(); ROT();
  }
  #undef CMASK
  #define CMASK(P0,P1,t) do{int jb_=(t)-(NT-4); if(jb_>=0)cmask(P0,P1,jb_,qrel,hi);}while(0)
  #define ENDW(tt) do{ if((tt)+3<NT){WAIT_BAR(2);} else if((tt)+2<NT){WAIT_BAR(1);} else {WAIT_BAR(0);} }while(0)
  for(;t+1<NT;t+=2){
    STEP(pB0,pB1,pA0,pA1,t,(t+3<NT),(t+1<NT),(t+1<NT));       ENDW(t);   RESC(); ROT();
    STEP(pA0,pA1,pB0,pB1,t+1,(t+4<NT),(t+2<NT),(t+2<NT));     ENDW(t+1); RESC(); ROT();
  }
  STEP(pB0,pB1,pA0,pA1,NT-1,false,false,false); RESC();
  { float sacc=pB0[0]+pB0[1]; _Pragma("unroll") for(int r=2;r<16;++r)sacc+=pB0[r]; _Pragma("unroll") for(int r=0;r<16;++r)sacc+=pB1[r]; l_reg+=sacc;
    pw0=(u32x4){PKW(pB0,0),PKW(pB0,2),PKW(pB0,4),PKW(pB0,6)};pw1=(u32x4){PKW(pB0,8),PKW(pB0,10),PKW(pB0,12),PKW(pB0,14)};pw2=(u32x4){PKW(pB1,0),PKW(pB1,2),PKW(pB1,4),PKW(pB1,6)};pw3=(u32x4){PKW(pB1,8),PKW(pB1,10),PKW(pB1,12),PKW(pB1,14)};
    SBAR(); pv(o,vb0+sl_cur,PAF(0),PAF(1),PAF(2),PAF(3)); }
  #undef PKW
  #undef PAF
  #undef VFR
  #undef PIN
  #undef MX3
  #undef GAPA
  #undef GAPB
  #undef EX
  #undef VRD
  #undef KRD
  #undef STEP
  #undef ENDW
  {auto rr=__builtin_amdgcn_permlane32_swap(__float_as_uint(l_reg),__float_as_uint(l_reg),false,false);l_reg=__uint_as_float(rr[0])+__uint_as_float(rr[1]);}
  if(hi==0)wsf[32+r32]=l_reg;asm volatile("s_waitcnt lgkmcnt(0)":::"memory");
  float rli[16];
  #pragma unroll
  for(int r=0;r<16;++r)rli[r]=__builtin_amdgcn_rcpf(wsf[32+crow(r,hi)]);
  bf16*Ow=O+(rowbase+q0+wid*QBLK)*DM+vcol;
  { bf16*stg=(bf16*)(shm+LDS_OST)+wid*2048;
    #pragma unroll
    for(int r=0;r<16;++r){const int orow=crow(r,hi);
      #pragma unroll
      for(int d0=0;d0<2;++d0)stg[orow*64+d0*32+r32]=__float2bfloat16(o[d0][r]*rli[r]);}
    asm volatile("s_waitcnt lgkmcnt(0)":::"memory");
    #pragma unroll
    for(int i=0;i<4;++i){const int row=i*8+(lane>>3),ch=lane&7; const u32x4 v=*(const u32x4*)(stg+row*64+ch*8); ATTN_STORE16(Ow+(long)row*DM+ch*8,v);} }
  asm volatile("s_waitcnt lgkmcnt(0)\n\ts_barrier":::"memory");
  #undef DMA_K
  #undef DMA_V
  #undef CMASK
  #undef START
  #undef RESC
  #undef ROT
}
constexpr int ATTN_LDS_BYTES=LDS_BYTES;
struct AttnTensors { const bf16* Q; const bf16* K; const bf16* V; bf16* O0; bf16* O1; };
struct AttnUnit { int bh; int qb; };
struct StaticOrder {
  int vcu;
  __device__ __forceinline__ explicit StaticOrder(int grid,int block):vcu((block%8)*(grid/8)+block/8){}
  __device__ __forceinline__ bool next(int i,AttnUnit&u)const{ if(i>=8)return false; const int s=vcu&7; u.bh=vcu; u.qb=(i+s)&7; return true; }
  __device__ __forceinline__ void a_ready(const AttnUnit&)const{}
  __device__ __forceinline__ void done(const AttnUnit&)const{}
};
template<class Sched,int THRL=8> __device__ __forceinline__ void attn_phase(char*lds,const AttnTensors&T,const Sched&S){
  AttnUnit u;
  for(int i=0;S.next(i,u);++i){ S.a_ready(u); { const int vh=u.bh&31,hh=vh>>2,cc=(vh>>1)&1,hf=vh&1; attn_unit<THRL>(u.bh>>5,(hh*2+cc)*64,hh*128+hf*64,u.qb,T.Q,T.K,T.V,cc?T.O1:T.O0,lds); } S.done(u); }
}
#undef SBAR
#undef WAIT_BAR
}

constexpr int NWAVES = 8;
constexpr int N_LAUNCHES = MK_N_LAUNCHES;
constexpr int NPHASE = 19;
constexpr int M = 16384, SEQ = 2048, D = 1024, NPROJ = 6144, RV = 2048, FF = 2816, FF2 = 5632;
constexpr float EPS = 1e-6f;
constexpr size_t MiB = 1u << 20;
constexpr size_t WS_CTL = 0, CTL_ZERO_BYTES = 1 * MiB;
constexpr size_t WS_COS = 1 * MiB, WS_SIN = 2 * MiB;
constexpr size_t WS_WA = 4 * MiB;
constexpr size_t WS_WB = 16 * MiB;
constexpr size_t WS_WC = 20 * MiB;
constexpr size_t WS_WD = 31 * MiB;
constexpr size_t WS_BIG = 37 * MiB;
constexpr size_t B_PROJ = WS_BIG;
constexpr size_t B_H = WS_BIG;
constexpr size_t B_UP = WS_BIG;
constexpr size_t B_XN = WS_BIG + 176 * MiB;
constexpr size_t B_SIDE = WS_BIG + 208 * MiB;
constexpr size_t B_XN2 = WS_BIG;
constexpr size_t B_QKV = WS_BIG + 32 * MiB;
constexpr size_t B_O0 = WS_BIG + 128 * MiB, B_O1 = WS_BIG + 160 * MiB;
constexpr size_t B_ON = WS_BIG;
constexpr size_t B_H2 = WS_BIG + 32 * MiB;
constexpr size_t WS_END = 256 * MiB;
static_assert(B_SIDE + (size_t)256 * 2 * FF * 2 <= WS_END && B_PROJ + (size_t)M * NPROJ * 2 <= WS_END && B_O1 + (size_t)M * D * 2 <= WS_END, "d_ws map");
constexpr int RING_OFF = 0, RING_BYTES = 131072;
constexpr int LDS_BYTES = 147456;

#define GAS __attribute__((address_space(1)))
#define LAS __attribute__((address_space(3)))
#define DI __device__ __forceinline__
typedef unsigned short bf16;
typedef unsigned v4u __attribute__((ext_vector_type(4)));
typedef unsigned v2u __attribute__((ext_vector_type(2)));
typedef float f32x4 __attribute__((ext_vector_type(4)));
typedef short bf16x8 __attribute__((ext_vector_type(8)));
typedef short v4i16 __attribute__((ext_vector_type(4)));
typedef float f32x2v __attribute__((ext_vector_type(2)));
typedef __bf16 bf16x2v __attribute__((ext_vector_type(2)));
#define LDS_WAIT() asm volatile("s_waitcnt lgkmcnt(0)" ::: "memory")

DI unsigned pk2(float lo, float hi) { f32x2v v = {lo, hi}; bf16x2v b = __builtin_convertvector(v, bf16x2v); return __builtin_bit_cast(unsigned, b); }
DI float bflo(unsigned w) { return __uint_as_float(w << 16); }
DI float bfhi(unsigned w) { return __uint_as_float(w & 0xffff0000u); }
DI float wave_sum(float v) {
#pragma unroll
    for (int o = 1; o < 64; o <<= 1) v += __shfl_xor(v, o);
    return v;
}

constexpr int CONV_TILE = 64 * 65 * 4;
DI void transpose_item(const float* W, int K, int N, bf16* WT, int row_off, const float* gain, int kmod, float cs, LAS float* scr, int item, int lane) {
    const int nblk = N / 64, kb = item / nblk, nb = item % nblk, k0 = 64 * kb, n0 = 64 * nb;
    const int lr = lane >> 4, lc = (lane & 15) * 4;
    f32x4 v[16];
#pragma unroll
    for (int i = 0; i < 16; ++i) v[i] = *(const f32x4*)(W + (size_t)(k0 + 4 * i + lr) * N + n0 + lc);
#pragma unroll
    for (int i = 0; i < 16; ++i) { const int kk = 4 * i + lr; float g = cs; if (gain) g *= gain[(k0 + kk) % kmod];
        LAS float* s = scr + kk * 65 + lc; s[0] = v[i].x * g; s[1] = v[i].y * g; s[2] = v[i].z * g; s[3] = v[i].w * g; }
    LDS_WAIT(); asm volatile("" ::: "memory");
    const int c = lane & 7;
#pragma unroll
    for (int j = 0; j < 8; ++j) { const int n = (lane >> 3) + 8 * j; const LAS float* s = scr + (8 * c) * 65 + n;
        v4u o; o.x = pk2(s[0 * 65], s[1 * 65]); o.y = pk2(s[2 * 65], s[3 * 65]); o.z = pk2(s[4 * 65], s[5 * 65]); o.w = pk2(s[6 * 65], s[7 * 65]);
        *(v4u*)(WT + (size_t)(row_off + n0 + n) * K + k0 + 8 * c) = o; }
    LDS_WAIT(); asm volatile("" ::: "memory");
}
DI void convert_matrix(const float* W, int K, int N, bf16* WT, int row_off, const float* gain, int kmod, float cs, LAS unsigned char* lds, int gw, int NGW, int wave, int lane) {
    LAS float* scr = (LAS float*)(lds + wave * CONV_TILE);
    const int nitems = (K / 64) * (N / 64);
    for (int it = gw; it < nitems; it += NGW) transpose_item(W, K, N, WT, row_off, gain, kmod, cs, scr, it, lane);
}

DI void norm_rows(const float* x, bf16* xn, int gw, int NGW, int lane) {
    for (int m = 2 * gw; m < M; m += 2 * NGW) {
        f32x4 v[2][4]; float s[2] = {0.f, 0.f};
#pragma unroll
        for (int r = 0; r < 2; ++r) { const f32x4* xr = (const f32x4*)(x + (size_t)(m + r) * D) + lane;
#pragma unroll
            for (int j = 0; j < 4; ++j) v[r][j] = xr[64 * j]; }
#pragma unroll
        for (int r = 0; r < 2; ++r) {
#pragma unroll
            for (int j = 0; j < 4; ++j) s[r] += (v[r][j].x * v[r][j].x + v[r][j].y * v[r][j].y) + (v[r][j].z * v[r][j].z + v[r][j].w * v[r][j].w);
            const float rstd = 1.0f / sqrtf(wave_sum(s[r]) * (1.f / D) + EPS);
            v2u* o8 = (v2u*)(xn + (size_t)(m + r) * D) + lane;
#pragma unroll
            for (int j = 0; j < 4; ++j) { v2u w; w.x = pk2(v[r][j].x * rstd, v[r][j].y * rstd); w.y = pk2(v[r][j].z * rstd, v[r][j].w * rstd); o8[64 * j] = w; } }
    }
}
DI void resid_rows(const bf16* h, const float* base, const float* gain, float* xo, bf16* xn, int gw, int NGW, int lane) {
    f32x4 gv[4];
#pragma unroll
    for (int j = 0; j < 4; ++j) gv[j] = ((const f32x4*)gain)[lane + 64 * j];
    for (int m = 2 * gw; m < M; m += 2 * NGW) {
        v2u hw[2][4]; f32x4 bv[2][4];
#pragma unroll
        for (int r = 0; r < 2; ++r) { const v2u* hr = (const v2u*)(h + (size_t)(m + r) * D) + lane; const f32x4* br = (const f32x4*)(base + (size_t)(m + r) * D) + lane;
#pragma unroll
            for (int j = 0; j < 4; ++j) { hw[r][j] = hr[64 * j]; bv[r][j] = br[64 * j]; } }
#pragma unroll
        for (int r = 0; r < 2; ++r) {
            f32x4 hv[4]; float s = 0.f;
#pragma unroll
            for (int j = 0; j < 4; ++j) { const v2u w = hw[r][j]; hv[j] = (f32x4){bflo(w.x), bfhi(w.x), bflo(w.y), bfhi(w.y)};
                s += (hv[j].x * hv[j].x + hv[j].y * hv[j].y) + (hv[j].z * hv[j].z + hv[j].w * hv[j].w); }
            const float rstd = 1.0f / sqrtf(wave_sum(s) * (1.f / D) + EPS);
            float s2 = 0.f;
#pragma unroll
            for (int j = 0; j < 4; ++j) { hv[j] = bv[r][j] + hv[j] * rstd * gv[j]; s2 += (hv[j].x * hv[j].x + hv[j].y * hv[j].y) + (hv[j].z * hv[j].z + hv[j].w * hv[j].w); }
            f32x4* orow = (f32x4*)(xo + (size_t)(m + r) * D) + lane;
#pragma unroll
            for (int j = 0; j < 4; ++j) orow[64 * j] = hv[j];
            if (xn) {
                const float r2 = 1.0f / sqrtf(wave_sum(s2) * (1.f / D) + EPS);
                v2u* o8 = (v2u*)(xn + (size_t)(m + r) * D) + lane;
#pragma unroll
                for (int j = 0; j < 4; ++j) { v2u w; w.x = pk2(hv[j].x * r2, hv[j].y * r2); w.y = pk2(hv[j].z * r2, hv[j].w * r2); o8[64 * j] = w; }
            }
        }
    }
}
DI void y_rows(bf16* outraw, const bf16* proj, int gw, int NGW, int lane) {
    for (int m = gw; m < M; m += NGW) {
#pragma unroll
        for (int hh = 0; hh < 4; ++hh) {
            v4u* op = (v4u*)(outraw + (size_t)m * RV + hh * 512) + lane;
            const v4u ov = *op; const v4u gvv = *((const v4u*)(proj + (size_t)m * NPROJ + 4096 + hh * 512) + lane);
            float o[8] = {bflo(ov.x), bfhi(ov.x), bflo(ov.y), bfhi(ov.y), bflo(ov.z), bfhi(ov.z), bflo(ov.w), bfhi(ov.w)};
            float g[8] = {bflo(gvv.x), bfhi(gvv.x), bflo(gvv.y), bfhi(gvv.y), bflo(gvv.z), bfhi(gvv.z), bflo(gvv.w), bfhi(gvv.w)};
            float s = 0.f;
#pragma unroll
            for (int e = 0; e < 8; ++e) s += o[e] * o[e];
            const float rstd = 1.0f / sqrtf(wave_sum(s) * (1.f / 512.f) + EPS);
            v4u w; w.x = pk2(o[0] * rstd * g[0], o[1] * rstd * g[1]); w.y = pk2(o[2] * rstd * g[2], o[3] * rstd * g[3]);
            w.z = pk2(o[4] * rstd * g[4], o[5] * rstd * g[5]); w.w = pk2(o[6] * rstd * g[6], o[7] * rstd * g[7]);
            *op = w;
        }
    }
}
DI void combine_rows(const bf16* O0, const bf16* O1, const float* lamp, float lambda_init, bf16* on, int gw, int NGW, int lane) {
    const float a = lamp[lane] * lamp[64 + lane], b = lamp[128 + lane] * lamp[192 + lane];
    const float lam = expf(wave_sum(a)) - expf(wave_sum(b)) + lambda_init;
    for (int m = gw; m < M; m += NGW) {
        const v4u* p0 = (const v4u*)(O0 + (size_t)m * D) + 2 * lane; const v4u* p1 = (const v4u*)(O1 + (size_t)m * D) + 2 * lane;
        const v4u a0 = p0[0], a1 = p0[1], b0 = p1[0], b1 = p1[1];
        const unsigned aw[8] = {a0.x, a0.y, a0.z, a0.w, a1.x, a1.y, a1.z, a1.w}, bw[8] = {b0.x, b0.y, b0.z, b0.w, b1.x, b1.y, b1.z, b1.w};
        float o[16]; float s = 0.f;
#pragma unroll
        for (int e = 0; e < 8; ++e) { o[2 * e] = bflo(aw[e]) - lam * bflo(bw[e]); o[2 * e + 1] = bfhi(aw[e]) - lam * bfhi(bw[e]); s += o[2 * e] * o[2 * e] + o[2 * e + 1] * o[2 * e + 1]; }
        s += __shfl_xor(s, 1); s += __shfl_xor(s, 2); s += __shfl_xor(s, 4);
        const float rstd = 1.0f / sqrtf(s * (1.f / 128.f) + EPS);
        v4u w0, w1; w0.x = pk2(o[0] * rstd, o[1] * rstd); w0.y = pk2(o[2] * rstd, o[3] * rstd); w0.z = pk2(o[4] * rstd, o[5] * rstd); w0.w = pk2(o[6] * rstd, o[7] * rstd);
        w1.x = pk2(o[8] * rstd, o[9] * rstd); w1.y = pk2(o[10] * rstd, o[11] * rstd); w1.z = pk2(o[12] * rstd, o[13] * rstd); w1.w = pk2(o[14] * rstd, o[15] * rstd);
        v4u* op = (v4u*)(on + (size_t)m * D) + 2 * lane; op[0] = w0; op[1] = w1;
    }
}
DI void conv_rows(bf16* up, const bf16* side, const float* cw, const float* cb, int G, int vb, int tid) {
    if (tid >= FF / 8) return;
    const int c0 = tid * 8;
    float wg[3][8], wu[3][8], bg[8], bu[8];
#pragma unroll
    for (int j = 0; j < 3; ++j)
#pragma unroll
        for (int e = 0; e < 8; ++e) { wg[j][e] = cw[j * FF2 + c0 + e]; wu[j][e] = cw[j * FF2 + FF + c0 + e]; }
#pragma unroll
    for (int e = 0; e < 8; ++e) { bg[e] = cb[c0 + e]; bu[e] = cb[FF + c0 + e]; }
    for (int blk = vb; blk < M / 64; blk += G) {
        const int t0 = blk * 64;
        float g2[8], g1[8], u2[8], u1[8];
        if ((t0 & (SEQ - 1)) == 0) {
#pragma unroll
            for (int e = 0; e < 8; ++e) { g2[e] = 0.f; g1[e] = 0.f; u2[e] = 0.f; u1[e] = 0.f; }
        } else {
            const v4u a = *(const v4u*)(side + (size_t)((blk - 1) * 2 + 0) * FF + c0), b = *(const v4u*)(side + (size_t)((blk - 1) * 2 + 1) * FF + c0);
            const v4u c = *(const v4u*)(up + (size_t)(t0 - 2) * FF2 + FF + c0), d = *(const v4u*)(up + (size_t)(t0 - 1) * FF2 + FF + c0);
            const unsigned aw[4] = {a.x, a.y, a.z, a.w}, bw[4] = {b.x, b.y, b.z, b.w}, cw4[4] = {c.x, c.y, c.z, c.w}, dw[4] = {d.x, d.y, d.z, d.w};
#pragma unroll
            for (int e = 0; e < 4; ++e) { g2[2 * e] = bflo(aw[e]); g2[2 * e + 1] = bfhi(aw[e]); g1[2 * e] = bflo(bw[e]); g1[2 * e + 1] = bfhi(bw[e]);
                u2[2 * e] = bflo(cw4[e]); u2[2 * e + 1] = bfhi(cw4[e]); u1[2 * e] = bflo(dw[e]); u1[2 * e + 1] = bfhi(dw[e]); }
        }
        for (int t = t0; t < t0 + 64; t += 4) {
            v4u gr[4], ur[4];
#pragma unroll
            for (int i = 0; i < 4; ++i) { gr[i] = *(const v4u*)(up + (size_t)(t + i) * FF2 + c0); ur[i] = *(const v4u*)(up + (size_t)(t + i) * FF2 + FF + c0); }
#pragma unroll
            for (int i = 0; i < 4; ++i) {
                const unsigned gw4[4] = {gr[i].x, gr[i].y, gr[i].z, gr[i].w}, uw4[4] = {ur[i].x, ur[i].y, ur[i].z, ur[i].w};
                float gc[8], uc[8], act[8];
#pragma unroll
                for (int e = 0; e < 4; ++e) { gc[2 * e] = bflo(gw4[e]); gc[2 * e + 1] = bfhi(gw4[e]); uc[2 * e] = bflo(uw4[e]); uc[2 * e + 1] = bfhi(uw4[e]); }
#pragma unroll
                for (int e = 0; e < 8; ++e) {
                    const float hg = bg[e] + wg[0][e] * g2[e] + wg[1][e] * g1[e] + wg[2][e] * gc[e];
                    const float hu = bu[e] + wu[0][e] * u2[e] + wu[1][e] * u1[e] + wu[2][e] * uc[e];
                    act[e] = hg * __builtin_amdgcn_rcpf(1.0f + __expf(-hg)) * hu;
                    g2[e] = g1[e]; g1[e] = gc[e]; u2[e] = u1[e]; u1[e] = uc[e];
                }
                v4u w; w.x = pk2(act[0], act[1]); w.y = pk2(act[2], act[3]); w.z = pk2(act[4], act[5]); w.w = pk2(act[6], act[7]);
                *(v4u*)(up + (size_t)(t + i) * FF2 + c0) = w;
            }
        }
    }
}

DI bf16x8 tr_frag(LAS const unsigned char* lo, int hi_off) {
    const v4i16 a = __builtin_amdgcn_ds_read_tr16_b64_v4i16((LAS v4i16*)lo);
    const v4i16 b = __builtin_amdgcn_ds_read_tr16_b64_v4i16((LAS v4i16*)(lo + hi_off));
    return (bf16x8){a[0], a[1], a[2], a[3], b[0], b[1], b[2], b[3]};
}
#define RET_BAR() asm volatile("s_waitcnt lgkmcnt(0)\n\ts_barrier" ::: "memory")
#define MFMA16(a, b, c) __builtin_amdgcn_mfma_f32_16x16x32_bf16((a), (b), (c), 0, 0, 0)
DI void retention_phase(LAS unsigned char* lds, const bf16* proj, bf16* outraw, int G, int vcu) {
    int tid_l = threadIdx.x; asm volatile("" : "+v"(tid_l));
    const int tid = tid_l, lane = tid & 63, wid = __builtin_amdgcn_readfirstlane(tid >> 6);
    const int fr = lane & 15, fq = lane >> 4, q = fr >> 2, p = fr & 3;
    const int rb = wid < 4 ? wid : 11 - wid;
    constexpr int KROW = 528, VROW = 144, SROW = 144;
    constexpr int KS_OFF = 0, VS_OFF = 128 * KROW, SS_OFF = VS_OFF + 128 * VROW;
    static_assert(SS_OFF + 256 * SROW <= RING_BYTES, "retention LDS");
    LAS unsigned char* KS = lds + KS_OFF; LAS unsigned char* VS = lds + VS_OFF; LAS unsigned char* SS = lds + SS_OFF;
    for (int item = vcu; item < 256; item += G) {
        const int b = item >> 5, h = (item >> 3) & 3, es = item & 7;
        const float l2g = log2f(1.0f - exp2f(-5.0f - (float)h));
        const float cd = exp2f(l2g * 128.0f);
        for (int i = tid; i < 256 * SROW / 4; i += NWAVES * 64) ((LAS unsigned*)SS)[i] = 0u;
        f32x4 st[2][4];
#pragma unroll
        for (int mi = 0; mi < 2; ++mi)
#pragma unroll
            for (int nb = 0; nb < 4; ++nb) st[mi][nb] = (f32x4){0.f, 0.f, 0.f, 0.f};
        const bf16* Qg = proj + (size_t)(b * SEQ) * NPROJ + h * 256;
        const bf16* Kg = Qg + 1024;
        const bf16* Vg = proj + (size_t)(b * SEQ) * NPROJ + 2048 + h * 512 + es * 64;
        bf16* Og = outraw + (size_t)(b * SEQ) * RV + h * 512 + es * 64;
        v4u Kp[8], Vp[2]; bf16x8 Qf[8];
#pragma unroll
        for (int i = 0; i < 8; ++i) { const int pc = tid + 512 * i, row = pc >> 5, c16 = pc & 31; Kp[i] = *(const v4u*)(Kg + (size_t)row * NPROJ + c16 * 8); }
#pragma unroll
        for (int i = 0; i < 2; ++i) { const int pc = tid + 512 * i, row = pc >> 3, c16 = pc & 7; Vp[i] = *(const v4u*)(Vg + (size_t)row * NPROJ + c16 * 8); }
#pragma unroll
        for (int ks = 0; ks < 8; ++ks) Qf[ks] = *(const bf16x8*)(Qg + (size_t)(16 * rb + fr) * NPROJ + ks * 32 + fq * 8);
        for (int c = 0; c < 16; ++c) {
#pragma unroll
            for (int i = 0; i < 8; ++i) { const int pc = tid + 512 * i, row = pc >> 5, c16 = pc & 31; *(LAS v4u*)(KS + row * KROW + c16 * 16) = Kp[i]; }
#pragma unroll
            for (int i = 0; i < 2; ++i) { const int pc = tid + 512 * i, row = pc >> 3, c16 = pc & 7; const v4u v = Vp[i];
                const float kd = exp2f(l2g * (float)(127 - row));
                v4u w; w.x = pk2(bflo(v.x) * kd, bfhi(v.x) * kd); w.y = pk2(bflo(v.y) * kd, bfhi(v.y) * kd); w.z = pk2(bflo(v.z) * kd, bfhi(v.z) * kd); w.w = pk2(bflo(v.w) * kd, bfhi(v.w) * kd);
                *(LAS v4u*)(VS + row * VROW + c16 * 16) = w; }
            if (c < 15) {
#pragma unroll
                for (int i = 0; i < 8; ++i) { const int pc = tid + 512 * i, row = pc >> 5, c16 = pc & 31; Kp[i] = *(const v4u*)(Kg + (size_t)((c + 1) * 128 + row) * NPROJ + c16 * 8); }
#pragma unroll
                for (int i = 0; i < 2; ++i) { const int pc = tid + 512 * i, row = pc >> 3, c16 = pc & 7; Vp[i] = *(const v4u*)(Vg + (size_t)((c + 1) * 128 + row) * NPROJ + c16 * 8); }
            }
            RET_BAR();
            f32x4 ao[4];
#pragma unroll
            for (int nb = 0; nb < 4; ++nb) ao[nb] = (f32x4){0.f, 0.f, 0.f, 0.f};
#pragma unroll
            for (int ks = 0; ks < 8; ++ks)
#pragma unroll
                for (int nb = 0; nb < 4; ++nb) { const bf16x8 B = tr_frag(SS + (32 * ks + 8 * fq + q) * SROW + (16 * nb + 4 * p) * 2, 4 * SROW); ao[nb] = MFMA16(Qf[ks], B, ao[nb]); }
#pragma unroll
            for (int kp = 0; kp < 4; ++kp) {
                if (2 * kp <= rb) {
                    f32x4 s0 = (f32x4){0.f, 0.f, 0.f, 0.f}, s1 = (f32x4){0.f, 0.f, 0.f, 0.f};
#pragma unroll
                    for (int ks = 0; ks < 8; ++ks) { const bf16x8 A = *(const LAS bf16x8*)(KS + (32 * kp + fr) * KROW + (32 * ks + 8 * fq) * 2); s0 = MFMA16(A, Qf[ks], s0); }
                    if (2 * kp == rb) {
#pragma unroll
                        for (int jj = 0; jj < 4; ++jj) if (4 * fq + jj > fr) s0[jj] = 0.f;
                    }
                    if (2 * kp + 1 <= rb) {
#pragma unroll
                        for (int ks = 0; ks < 8; ++ks) { const bf16x8 A = *(const LAS bf16x8*)(KS + (32 * kp + 16 + fr) * KROW + (32 * ks + 8 * fq) * 2); s1 = MFMA16(A, Qf[ks], s1); }
                        if (2 * kp + 1 == rb) {
#pragma unroll
                            for (int jj = 0; jj < 4; ++jj) if (4 * fq + jj > fr) s1[jj] = 0.f;
                        }
                    }
                    v4u pw; pw.x = pk2(s0[0], s0[1]); pw.y = pk2(s0[2], s0[3]); pw.z = pk2(s1[0], s1[1]); pw.w = pk2(s1[2], s1[3]);
                    const bf16x8 Pa = __builtin_bit_cast(bf16x8, pw);
#pragma unroll
                    for (int nb = 0; nb < 4; ++nb) { const bf16x8 B = tr_frag(VS + (32 * kp + 4 * fq + q) * VROW + (16 * nb + 4 * p) * 2, 16 * VROW); ao[nb] = MFMA16(Pa, B, ao[nb]); }
                }
            }
#pragma unroll
            for (int jj = 0; jj < 4; ++jj) { const int il = 16 * rb + 4 * fq + jj; const float sc = exp2f(l2g * (float)(il - 127));
                bf16* orow = Og + (size_t)(c * 128 + il) * RV + fr;
#pragma unroll
                for (int nb = 0; nb < 4; ++nb) orow[16 * nb] = (bf16)(pk2(ao[nb][jj] * sc, 0.f) & 0xffffu); }
            if (c < 15) {
#pragma unroll
                for (int ks = 0; ks < 8; ++ks) Qf[ks] = *(const bf16x8*)(Qg + (size_t)((c + 1) * 128 + 16 * rb + fr) * NPROJ + ks * 32 + fq * 8);
            }
#pragma unroll
            for (int mi = 0; mi < 2; ++mi)
#pragma unroll
                for (int nb = 0; nb < 4; ++nb) st[mi][nb] = st[mi][nb] * cd;
#pragma unroll
            for (int ks = 0; ks < 4; ++ks) {
                bf16x8 A[2], B[4];
#pragma unroll
                for (int mi = 0; mi < 2; ++mi) A[mi] = tr_frag(KS + (32 * ks + 8 * fq + q) * KROW + (16 * (2 * wid + mi) + 4 * p) * 2, 4 * KROW);
#pragma unroll
                for (int nb = 0; nb < 4; ++nb) B[nb] = tr_frag(VS + (32 * ks + 8 * fq + q) * VROW + (16 * nb + 4 * p) * 2, 4 * VROW);
#pragma unroll
                for (int mi = 0; mi < 2; ++mi)
#pragma unroll
                    for (int nb = 0; nb < 4; ++nb) st[mi][nb] = MFMA16(A[mi], B[nb], st[mi][nb]);
            }
            RET_BAR();
            if (c < 15) {
#pragma unroll
                for (int mi = 0; mi < 2; ++mi)
#pragma unroll
                    for (int nb = 0; nb < 4; ++nb)
#pragma unroll
                        for (int jj = 0; jj < 4; ++jj)
                            *(LAS unsigned short*)(SS + (16 * (2 * wid + mi) + 4 * fq + jj) * SROW + (16 * nb + fr) * 2) = (unsigned short)(pk2(st[mi][nb][jj] * cd, 0.f) & 0xffffu);
            }
        }
    }
}

typedef GAS unsigned gu32;
#define RLX_AGENT __ATOMIC_RELAXED, __HIP_MEMORY_SCOPE_AGENT
#define XB_TMO      128
#define XB_XCNT(j)  (256  + 64 * (j))
#define XB_XSUB(j)  (1280 + 64 * (j))
#define XB_XGEN(j)  (2304 + 64 * (j))
#define XB_TOP      3328
#define XB_TOPGEN   3392
#define XCD_BAR_WORDS 3456
#define XB_SPIN_CAP (1u << 18)

__device__ __forceinline__ unsigned xb_ld(unsigned* p)              { return __hip_atomic_load(p, __ATOMIC_RELAXED, __HIP_MEMORY_SCOPE_AGENT); }
__device__ __forceinline__ unsigned xb_add(unsigned* p, unsigned v) { return __hip_atomic_fetch_add(p, v, __ATOMIC_RELAXED, __HIP_MEMORY_SCOPE_AGENT); }
__device__ __forceinline__ unsigned xb_xcc_id() { return (unsigned)__builtin_amdgcn_s_getreg((3 << 11) | 20) & 0xFu; }
#define XB_SPIN(cond, bar) do { unsigned _sp = 0; while (cond) { __builtin_amdgcn_s_sleep(1); \
    if ((++_sp & 255u) == 0u) { if (xb_ld(&(bar)[XB_TMO])) break; if (_sp > XB_SPIN_CAP) { atomicAdd(&(bar)[XB_TMO], 1u); break; } } } } while (0)

struct XcdBarrier {
    unsigned* bar; unsigned x;
    volatile LAS unsigned* st;
};

__device__ __forceinline__ XcdBarrier xcd_barrier_post(unsigned* bar, volatile LAS unsigned* st) {
    XcdBarrier b; b.bar = bar; b.x = xb_xcc_id(); b.st = st;
    if (threadIdx.x == 0) (void)xb_add(&bar[XB_XCNT(b.x)], 1u);
    return b;
}
__device__ __forceinline__ void xcd_barrier_complete(unsigned* bar, unsigned x, unsigned& nloc, unsigned& nx) {
    const unsigned G = gridDim.x * gridDim.y * gridDim.z;
    unsigned sum, cnt, mine, sp = 0u;
    for (;;) {
        sum = 0u; cnt = 0u; mine = 0u;
#pragma unroll
        for (unsigned j = 0; j < 16; ++j) { const unsigned c = xb_ld(&bar[XB_XCNT(j)]); sum += c; cnt += (c > 0u) ? 1u : 0u; mine = (j == x) ? c : mine; }
        if (sum == G) break;
        __builtin_amdgcn_s_sleep(1);
        if ((++sp & 255u) == 0u) { if (xb_ld(&bar[XB_TMO])) break; if (sp > XB_SPIN_CAP) { atomicAdd(&bar[XB_TMO], 1u); break; } }
    }
    nloc = mine > 0u ? mine : 1u; nx = cnt > 0u ? cnt : 1u;
}

__device__ __forceinline__ void xcd_barrier(const XcdBarrier& b) {
    asm volatile("s_waitcnt vmcnt(0)" ::: "memory");
    __syncthreads();
    if (threadIdx.x == 0) {
        unsigned* bar = b.bar;
        __builtin_amdgcn_s_waitcnt(0);
        unsigned nloc = b.st[0], nx = b.st[1];
        if (nloc == 0u) { xcd_barrier_complete(bar, b.x, nloc, nx); b.st[0] = nloc; b.st[1] = nx; }
        const unsigned old = xb_add(&bar[XB_XSUB(b.x)], 1u);
        const unsigned gen = old / nloc;
        if (old + 1u == (gen + 1u) * nloc) {
            __builtin_amdgcn_fence(__ATOMIC_RELEASE, "agent");
            asm volatile("s_waitcnt vmcnt(0)" ::: "memory");
            const unsigned og = xb_add(&bar[XB_TOP], 1u);
            const unsigned tg = og / nx;
            if (og + 1u == (tg + 1u) * nx) xb_add(&bar[XB_TOPGEN], 1u);
            else XB_SPIN(xb_ld(&bar[XB_TOPGEN]) == tg, bar);
            __builtin_amdgcn_fence(__ATOMIC_ACQUIRE, "agent");
            xb_add(&bar[XB_XGEN(b.x)], 1u);
            asm volatile("s_waitcnt vmcnt(0)" ::: "memory");
        } else {
            XB_SPIN(xb_ld(&bar[XB_XGEN(b.x)]) == gen, bar);
            __builtin_amdgcn_fence(__ATOMIC_ACQUIRE, "agent");
            asm volatile("s_waitcnt vmcnt(0)" ::: "memory");
        }
    }
    __syncthreads();
}
constexpr int CW_BAR = 4096, MISC_OFF = LDS_BYTES - 2048;
constexpr int PTR_OFF = LDS_BYTES - 1024;
static_assert(8 * CONV_TILE <= LDS_BYTES - 2048, "conversion tiles vs LDS control words");
DI const float* inptr(LAS unsigned char* lds, int k) {
    volatile LAS unsigned* t = (volatile LAS unsigned*)(lds + PTR_OFF);
    const unsigned lo = __builtin_amdgcn_readfirstlane(t[2 * k]), hi = __builtin_amdgcn_readfirstlane(t[2 * k + 1]);
    return (const float*)(((unsigned long long)hi << 32) | (unsigned long long)lo);
}
#define PH_IDS int tid = threadIdx.x; asm volatile("" : "+v"(tid)); const int lane = tid & 63, wave = __builtin_amdgcn_readfirstlane(tid >> 6); \
    const int gw = vcu * NWAVES + wave, NGW = G * NWAVES; (void)lane; (void)gw; (void)NGW;
#define WPTR(off) ((bf16*)(ws + (off)))

#define FFN_PHASES(L, pb) \
        for (int rep = 0; rep < NREP(pb); ++rep) if (IN(pb)) { \
            pg8::Gemm g{(const bf16*)(ws + B_XN), WPTR(WS_WC), M, FF2, D, D}; pg8::StaticOrder S; S.init(M, FF2, G, bx); \
            pg8::EpiOut E{(bf16*)(ws + B_UP), FF2, 0, 0, 1.f, (bf16*)(ws + B_SIDE), FF / 256, FF}; \
            pg8::gemm_phase<pg8::EpiOut, pg8::StaticOrder, true, true>(lds + RING_OFF, g, S, E); \
        } \
        SEAM(pb); \
        if (IN(pb + 1)) { PH_IDS \
            conv_rows((bf16*)(ws + B_UP), (const bf16*)(ws + B_SIDE), inptr(lds, 16) + (size_t)L * 3 * FF2, inptr(lds, 17) + (size_t)L * FF2, G, vcu, tid); \
            if (L == 0) convert_matrix(inptr(lds, 15) + (size_t)D * FF2, D, FF2, WPTR(WS_WC), 0, inptr(lds, 13) + D, D, 1.f, lds, gw, NGW, wave, lane); \
            __syncthreads(); \
        } \
        SEAM(pb + 1); \
        for (int rep = 0; rep < NREP(pb + 2); ++rep) if (IN(pb + 2)) { \
            pg8::Gemm g{(const bf16*)(ws + B_UP), WPTR(WS_WD), M, D, FF, FF2}; pg8::StaticOrder S; S.init(M, D, G, bx); \
            pg8::EpiOut E{(bf16*)(ws + B_XN), D, 0, 0, 1.f, nullptr, 0, 0}; \
            pg8::gemm_phase<pg8::EpiOut, pg8::StaticOrder, true, true>(lds + RING_OFF, g, S, E); \
        } \
        SEAM(pb + 2); \
        if (IN(pb + 3)) { PH_IDS \
            resid_rows((const bf16*)(ws + B_XN), out, inptr(lds, 14) + (size_t)L * D, out, L == 0 ? (bf16*)(ws + B_XN2) : (bf16*)nullptr, gw, NGW, lane); \
            if (L == 0) convert_matrix(inptr(lds, 18) + (size_t)FF * D, FF, D, WPTR(WS_WD), 0, nullptr, FF, 1.f, lds, gw, NGW, wave, lane); \
            __syncthreads(); \
        }
struct Args { const float* in[19]; float* out; unsigned char* ws; int ph_lo, ph_hi; float lambda_init; int pad; };
__global__ void __launch_bounds__(NWAVES * 64, 2) yoco_fwd(Args args) {
    extern __shared__ __attribute__((aligned(16))) unsigned char lds_raw[];
    LAS unsigned char* lds = (LAS unsigned char*)lds_raw;
    const int G = gridDim.x; const int bx = blockIdx.x;
    const int vcu = (G % 8 == 0) ? (bx % 8) * (G / 8) + bx / 8 : bx;
    unsigned char* ws = args.ws;
    float* out = args.out;
    const int lo = args.ph_lo, hi = args.ph_hi;
    { const int t0 = threadIdx.x; if (t0 < 19) ((LAS unsigned long long*)(lds + PTR_OFF))[t0] = (unsigned long long)args.in[t0]; }
    if (threadIdx.x < 2) ((volatile LAS unsigned*)(lds + MISC_OFF))[threadIdx.x] = 0u;
    __syncthreads();
    XcdBarrier xbar; xbar.bar = (unsigned*)(ws + WS_CTL) + CW_BAR; xbar.x = 0; xbar.st = nullptr;
    if (N_LAUNCHES == 1) xbar = xcd_barrier_post((unsigned*)(ws + WS_CTL) + CW_BAR, (volatile LAS unsigned*)(lds + MISC_OFF));
#ifndef PHMASK
#define PHMASK 0x7ffff
#endif
#define IN(k) (((PHMASK >> ((k) > 14 ? (k) - 9 : (k))) & 1) && lo <= (k) && (k) < hi)
#ifndef PROBE_DUP
#define PROBE_DUP 0
#endif
#define NREP(k) (((PROBE_DUP >> (k)) & 1) ? 2 : 1)
#define SEAM(k) do { if (IN(k) && IN((k) + 1)) { xcd_barrier(xbar); } } while (0)

    for (int rep = 0; rep < NREP(0); ++rep) if (IN(0)) { PH_IDS
        float* cosT = (float*)(ws + WS_COS); float* sinT = (float*)(ws + WS_SIN);
        for (int i = (vcu * NWAVES * 64 + tid); i < SEQ * 128; i += G * NWAVES * 64) { const int pos = i >> 7, j = i & 127;
            const float inv = 1.0f / exp2f(13.287712379549449f * ((float)j / 127.0f)); const float ang = (float)pos * inv;
            const double rev = (double)ang * 0.15915494309189535; const float fr = (float)(rev - floor(rev));
            cosT[i] = __builtin_amdgcn_cosf(fr); sinT[i] = __builtin_amdgcn_sinf(fr); }
        convert_matrix(inptr(lds, 3), D, NPROJ, WPTR(WS_WA), 0, inptr(lds, 1), D, 1.f, lds, gw, NGW, wave, lane);
        convert_matrix(inptr(lds, 4), RV, D, WPTR(WS_WB), 0, nullptr, RV, 1.f, lds, gw, NGW, wave, lane);
        convert_matrix(inptr(lds, 15), D, FF2, WPTR(WS_WC), 0, inptr(lds, 13), D, 1.f, lds, gw, NGW, wave, lane);
        convert_matrix(inptr(lds, 18), FF, D, WPTR(WS_WD), 0, nullptr, FF, 1.f, lds, gw, NGW, wave, lane);
        norm_rows(inptr(lds, 0), (bf16*)out, gw, NGW, lane);
        __syncthreads();
    }
    SEAM(0);
    for (int rep = 0; rep < NREP(1); ++rep) if (IN(1)) {
        pg8::Gemm g{(const bf16*)out, WPTR(WS_WA), M, NPROJ, D, D}; pg8::StaticOrder S; S.init(M, NPROJ, G, bx);
        pg8::EpiProj E{(bf16*)(ws + B_PROJ), NPROJ, (const float*)(ws + WS_COS), (const float*)(ws + WS_SIN)};
        pg8::gemm_phase<pg8::EpiProj, pg8::StaticOrder, true, true>(lds + RING_OFF, g, S, E);
    }
    SEAM(1);
    for (int rep = 0; rep < NREP(2); ++rep) if (IN(2)) { retention_phase(lds + RING_OFF, (const bf16*)(ws + B_PROJ), (bf16*)out, G, vcu); __syncthreads(); }
    SEAM(2);
    if (IN(3)) { PH_IDS
        y_rows((bf16*)out, (const bf16*)(ws + B_PROJ), gw, NGW, lane);
        convert_matrix(inptr(lds, 9), D, D, WPTR(WS_WA), 0, inptr(lds, 7), D, 1.f, lds, gw, NGW, wave, lane);
        convert_matrix(inptr(lds, 6), D, 2 * D, WPTR(WS_WA), D, inptr(lds, 5), D, 1.f, lds, gw, NGW, wave, lane);
        convert_matrix(inptr(lds, 12), D, D, WPTR(WS_WA + 8 * MiB), 0, inptr(lds, 11), 128, 1.0f - args.lambda_init, lds, gw, NGW, wave, lane);
        __syncthreads();
    }
    SEAM(3);
    for (int rep = 0; rep < NREP(4); ++rep) if (IN(4)) {
        pg8::Gemm g{(const bf16*)out, WPTR(WS_WB), M, D, RV, RV}; pg8::StaticOrder S; S.init(M, D, G, bx);
        pg8::EpiOut E{(bf16*)(ws + B_H), D, 0, 0, 1.f, nullptr, 0, 0};
        pg8::gemm_phase<pg8::EpiOut, pg8::StaticOrder, true, true>(lds + RING_OFF, g, S, E);
    }
    SEAM(4);
    for (int rep = 0; rep < NREP(5); ++rep) if (IN(5)) { PH_IDS resid_rows((const bf16*)(ws + B_H), inptr(lds, 0), inptr(lds, 2), out, (bf16*)(ws + B_XN), gw, NGW, lane); }
    SEAM(5);
    FFN_PHASES(0, 6)
    SEAM(9);
    if (IN(10)) {
        pg8::Gemm g{(const bf16*)(ws + B_XN2), WPTR(WS_WA), M, 3 * D, D, D}; pg8::StaticOrder S; S.init(M, 3 * D, G, bx);
        pg8::EpiOut E{(bf16*)(ws + B_QKV), D, D, (size_t)M * D, attn_body::C2, nullptr, 0, 0};
        pg8::gemm_phase<pg8::EpiOut, pg8::StaticOrder, true, true>(lds + RING_OFF, g, S, E);
    }
    SEAM(10);
    for (int rep = 0; rep < NREP(11); ++rep) if (IN(11)) {
        const attn_body::bf16* Qp = (const attn_body::bf16*)(ws + B_QKV);
        const attn_body::AttnTensors AT{Qp, Qp + (size_t)M * D, Qp + (size_t)2 * M * D, (attn_body::bf16*)(ws + B_O0), (attn_body::bf16*)(ws + B_O1)};
        const attn_body::StaticOrder S((int)G, (int)bx);
        attn_body::attn_phase<attn_body::StaticOrder>((char*)lds_raw + RING_OFF, AT, S);
        __syncthreads();
    }
    SEAM(11);
    for (int rep = 0; rep < NREP(12); ++rep) if (IN(12)) { PH_IDS combine_rows((const bf16*)(ws + B_O0), (const bf16*)(ws + B_O1), inptr(lds, 10), args.lambda_init, (bf16*)(ws + B_ON), gw, NGW, lane); }
    SEAM(12);
    if (IN(13)) {
        pg8::Gemm g{(const bf16*)(ws + B_ON), WPTR(WS_WA + 8 * MiB), M, D, D, D}; pg8::StaticOrder S; S.init(M, D, G, bx);
        pg8::EpiOut E{(bf16*)(ws + B_H2), D, 0, 0, 1.f, nullptr, 0, 0};
        pg8::gemm_phase<pg8::EpiOut, pg8::StaticOrder, true, true>(lds + RING_OFF, g, S, E);
    }
    SEAM(13);
    if (IN(14)) { PH_IDS resid_rows((const bf16*)(ws + B_H2), out, inptr(lds, 8), out, (bf16*)(ws + B_XN), gw, NGW, lane); }
    SEAM(14);
    FFN_PHASES(1, 15)
#undef IN
#undef SEAM
}

extern "C" void kernel_launch(void* const* d_in, const int* in_sizes, int n_in, void* d_out, int out_size, void* d_ws, size_t ws_size, hipStream_t stream) {
    static int grid = 0;
    if (grid == 0) {
        if (n_in != 19 || in_sizes[0] != M * D || out_size != M * D || ws_size < WS_END) { fprintf(stderr, "kernel_launch: unexpected shapes (n_in %d, in0 %d, out %d, ws %zu); nothing launched\n", n_in, n_in > 0 ? in_sizes[0] : -1, out_size, ws_size); grid = -1; return; }
        int dev = 0, cus = 0, per_cu = 0;
        if (hipGetDevice(&dev) != hipSuccess || hipDeviceGetAttribute(&cus, hipDeviceAttributeMultiprocessorCount, dev) != hipSuccess) { grid = -1; return; }
        if (hipFuncSetAttribute((const void*)yoco_fwd, hipFuncAttributeMaxDynamicSharedMemorySize, LDS_BYTES) != hipSuccess) { fprintf(stderr, "kernel_launch: hipFuncSetAttribute failed\n"); grid = -1; return; }
        if (hipOccupancyMaxActiveBlocksPerMultiprocessor(&per_cu, (const void*)yoco_fwd, NWAVES * 64, LDS_BYTES) != hipSuccess || per_cu < 1) { fprintf(stderr, "kernel_launch: occupancy query says %d\n", per_cu); per_cu = 1; }
        (void)hipGetLastError();
        grid = cus;
    }
    if (grid < 0) return;
    if (hipMemsetAsync((char*)d_ws + WS_CTL, 0, 65536, stream) != hipSuccess) { fprintf(stderr, "kernel_launch: hipMemsetAsync failed\n"); return; }
    Args a{};
    for (int i = 0; i < 19; ++i) a.in[i] = (const float*)d_in[i];
    a.out = (float*)d_out; a.ws = (unsigned char*)d_ws;
    a.lambda_init = (float)(0.8 - 0.6 * exp(-0.3 * 1.0));
    if (N_LAUNCHES == 1) {
        a.ph_lo = 0; a.ph_hi = NPHASE;
        hipLaunchKernelGGL(yoco_fwd, dim3(grid), dim3(NWAVES * 64), LDS_BYTES, stream, a);
        const hipError_t le = hipPeekAtLastError();
        if (le != hipSuccess) fprintf(stderr, "kernel_launch: launch failed: %s (grid %d)\n", hipGetErrorName(le), grid);
    } else {
        for (int p = 0; p < NPHASE; ++p) {
            a.ph_lo = p; a.ph_hi = p + 1;
            hipLaunchKernelGGL(yoco_fwd, dim3(grid), dim3(NWAVES * 64), LDS_BYTES, stream, a);
            const hipError_t le = hipPeekAtLastError();
            if (le != hipSuccess) { fprintf(stderr, "kernel_launch: launch %d failed: %s\n", p, hipGetErrorName(le)); break; }
        }
    }
}
```
